# Optimizing an MI355X kernel written in HIP

```python
import math
import functools
import jax
import jax.numpy as jnp
from jax import lax
import numpy as np

D_MODEL = 2048
BATCH = 4
SEQ = 2048
DEPTH = 1
DEC_BATCH = 8
DEC_SEQ = 1
PAST_LEN = 16384
PAGE_SIZE = 128

HEAD_DIM = 128
N_HEADS = D_MODEL // HEAD_DIM
N_KV_HEADS = 4
GROUP = N_HEADS // N_KV_HEADS
ROPE_DIM = HEAD_DIM // 4
IDX_HEADS = 16
IDX_DIM = 64
IDX_ROPE_DIM = IDX_DIM // 4
TOPK_MAX = 256
ROPE_THETA = 500000.0
Q_BLOCK = 128
GDN_DK = 128
GDN_DV = 128
GDN_HEADS = D_MODEL // GDN_DV
CONV_W = 4
CONV_DIM = 2 * GDN_HEADS * GDN_DK + GDN_HEADS * GDN_DV
CHUNK = 64
D_FF = 5632
LN_EPS = 1e-5
NORM_EPS = 1e-6
DN_ALPHA = (2 * DEPTH) ** 0.25
DN_BETA = (8 * DEPTH) ** -0.25

IN_SPLITS = (
    ('q_a', N_HEADS * HEAD_DIM), ('k_a', N_KV_HEADS * HEAD_DIM), ('v_a', N_KV_HEADS * HEAD_DIM),
    ('q_idx', IDX_HEADS * IDX_DIM), ('k_idx', IDX_DIM), ('w_idx', IDX_HEADS),
    ('qkv_b', CONV_DIM), ('a_b', GDN_HEADS), ('beta_b', GDN_HEADS), ('z_b', GDN_HEADS * GDN_DV),
    ('gate_a', D_MODEL), ('gate_b', D_MODEL),
)
IN_COLS = sum(n for _, n in IN_SPLITS)

kernel_name = 'hybrid_dsa_gdn_macaron_step'


def _layer_norm(x, g, b):
    xf = x.astype(jnp.float32)
    mu = jnp.mean(xf, axis=-1, keepdims=True)
    var = jnp.mean(jnp.square(xf - mu), axis=-1, keepdims=True)
    return ((xf - mu) * lax.rsqrt(var + LN_EPS) * g.astype(jnp.float32) + b.astype(jnp.float32)).astype(x.dtype)


def _rms_norm(x, g):
    xf = x.astype(jnp.float32)
    return xf * lax.rsqrt(jnp.mean(jnp.square(xf), axis=-1, keepdims=True) + NORM_EPS) * g.astype(jnp.float32)


def _l2norm(x):
    xf = x.astype(jnp.float32)
    return xf * lax.rsqrt(jnp.sum(jnp.square(xf), axis=-1, keepdims=True) + NORM_EPS)


def _swiglu(x, wg, wu, wd):
    return (jax.nn.silu(x @ wg) * (x @ wu)) @ wd


def _split_columns(u):
    offs = np.cumsum([n for _, n in IN_SPLITS])[:-1].tolist()
    return dict(zip([nm for nm, _ in IN_SPLITS], jnp.split(u, offs, axis=-1)))


def _rope(x, pos, rot_dim):
    half = rot_dim // 2
    inv = ROPE_THETA ** (-jnp.arange(half, dtype=jnp.float32) / half)
    ang = pos.astype(jnp.float32)[:, None] * inv[None, :]
    cos = jnp.cos(ang)[:, None, :]
    sin = jnp.sin(ang)[:, None, :]
    xf = x.astype(jnp.float32)
    x1, x2, rest = xf[..., :half], xf[..., half:rot_dim], xf[..., rot_dim:]
    out = jnp.concatenate([x1 * cos - x2 * sin, x2 * cos + x1 * sin, rest], axis=-1)
    return out.astype(x.dtype)


def _causal_conv(x, buf, w):
    T = x.shape[1]
    xp = jnp.concatenate([buf.astype(x.dtype), x], axis=1)
    y = w[0] * xp[:, 0:T]
    for j in range(1, CONV_W):
        y = y + w[j] * xp[:, j:j + T]
    return jax.nn.silu(y), xp[:, xp.shape[1] - (CONV_W - 1):]


def _gated_delta(q, k, v, g, beta, s0):
    B, T, H, dk = q.shape
    dv = v.shape[-1]
    pad = (-T) % CHUNK
    def padt(a):
        return jnp.pad(a, [(0, 0), (0, pad)] + [(0, 0)] * (a.ndim - 2))
    nc = (T + pad) // CHUNK
    def chunks(a):
        a = padt(a.astype(jnp.float32))
        return jnp.moveaxis(a.reshape((B, nc, CHUNK, H) + a.shape[3:]), 3, 1)
    q, k, v, g, beta = chunks(q), chunks(k), chunks(v), chunks(g), chunks(beta)
    G = jnp.cumsum(g, axis=-1)
    tri_incl = jnp.tril(jnp.ones((CHUNK, CHUNK), dtype=bool))
    tri_strict = jnp.tril(jnp.ones((CHUNK, CHUNK), dtype=bool), -1)
    diff = G[..., :, None] - G[..., None, :]
    decay_incl = jnp.where(tri_incl, jnp.exp(jnp.where(tri_incl, diff, 0.0)), 0.0)
    decay_strict = jnp.where(tri_strict, decay_incl, 0.0)
    kb = k * beta[..., None]
    a_mat = jnp.einsum('bhnid,bhnjd->bhnij', kb, k) * decay_strict + jnp.eye(CHUNK, dtype=jnp.float32)
    u = lax.linalg.triangular_solve(a_mat, v * beta[..., None], left_side=True, lower=True, unit_diagonal=True)
    w = lax.linalg.triangular_solve(a_mat, kb * jnp.exp(G)[..., None], left_side=True, lower=True, unit_diagonal=True)
    qk = jnp.einsum('bhnid,bhnjd->bhnij', q, k) * decay_incl
    xs = tuple(jnp.moveaxis(a, 2, 0) for a in (q, k, u, w, G, qk))

    def step(S, c):
        qc, kc, uc, wc, Gc, qkc = c
        v_new = uc - jnp.einsum('bhcd,bhde->bhce', wc, S)
        o = jnp.einsum('bhcd,bhde->bhce', qc * jnp.exp(Gc)[..., None], S) + jnp.einsum('bhij,bhje->bhie', qkc, v_new)
        g_last = Gc[..., -1:]
        S = S * jnp.exp(g_last)[..., None] + jnp.einsum('bhcd,bhce->bhde', kc * jnp.exp(g_last - Gc)[..., None], v_new)
        return S, o

    S, o = lax.scan(step, s0.astype(jnp.float32), xs)
    o = jnp.moveaxis(jnp.moveaxis(o, 0, 2), 1, 3).reshape(B, nc * CHUNK, H, dv)[:, :T]
    return o, S


def _indexer_select(qi, wi, ki, qpos, ktop):
    L = ki.shape[1]
    s = jax.nn.relu(jnp.einsum('bthd,bld->bthl', qi, ki))
    score = jnp.einsum('bth,bthl->btl', wi, s).astype(jnp.float32)
    allowed = jnp.arange(L, dtype=jnp.int32)[None, :] <= qpos[:, None]
    score = jnp.where(allowed[None], score, -jnp.inf)
    _, sel = lax.top_k(score, ktop)
    valid = sel <= qpos[None, :, None]
    return sel, valid


def _gather_rows(a, sel):
    return a[jnp.arange(a.shape[0])[:, None, None], sel]


def _sparse_attend(q, ks, vs, valid):
    s = jnp.einsum('btngd,btknd->btngk', q, ks).astype(jnp.float32) * (HEAD_DIM ** -0.5)
    s = jnp.where(valid[:, :, None, None, :], s, -jnp.inf)
    p = jax.nn.softmax(s, axis=-1)
    return jnp.einsum('btngk,btknd->btngd', p.astype(vs.dtype), vs)


def _dsa_prompt(q, k, v, qi, ki, wi):
    B, S = q.shape[:2]
    ktop = min(TOPK_MAX, S // 4)
    nb = S // Q_BLOCK
    def blocks(a):
        return jnp.moveaxis(a.reshape((B, nb, Q_BLOCK) + a.shape[2:]), 1, 0)
    qpos = jnp.arange(S, dtype=jnp.int32).reshape(nb, Q_BLOCK)

    def one_block(args):
        qb, qib, wib, pb = args
        sel, valid = _indexer_select(qib, wib, ki, pb, ktop)
        return _sparse_attend(qb, _gather_rows(k, sel), _gather_rows(v, sel), valid)

    o = lax.map(one_block, (blocks(q), blocks(qi), blocks(wi), qpos))
    return jnp.moveaxis(o, 0, 1).reshape(q.shape)


def _gather_paged(pool, page_table, new_rows, sel):
    DB, T = new_rows.shape[:2]
    bidx = jnp.arange(DB)[:, None, None]
    ps = jnp.minimum(sel, PAST_LEN - 1)
    phys = page_table[bidx, ps // PAGE_SIZE]
    past = pool[phys, ps % PAGE_SIZE].astype(new_rows.dtype)
    new = new_rows[bidx, jnp.clip(sel - PAST_LEN, 0, T - 1)]
    return jnp.where((sel < PAST_LEN)[..., None, None], past, new)


def _dsa_sample(q, k, v, qi, ki, wi, cache_k, cache_v, cache_ki, page_table):
    DB, T = q.shape[:2]
    ktop = min(TOPK_MAX, (PAST_LEN + T) // 4)
    qpos = PAST_LEN + jnp.arange(T, dtype=jnp.int32)
    ki_past = cache_ki[page_table].reshape(DB, PAST_LEN, IDX_DIM)
    ki_all = jnp.concatenate([ki_past.astype(ki.dtype), ki], axis=1)
    sel, valid = _indexer_select(qi, wi, ki_all, qpos, ktop)
    ks = _gather_paged(cache_k, page_table, k, sel)
    vs = _gather_paged(cache_v, page_table, v, sel)
    return _sparse_attend(q, ks, vs, valid)


def _layer(x, pos, w, dsa_fn, conv_buf, ssm0):
    (ffn1_g, ffn1_u, ffn1_d, ln1_g, ln1_b, w_in, conv_w, a_log, dt_bias, gdn_norm_g,
     w_o, ln2_g, ln2_b, ffn2_g, ffn2_u, ffn2_d, ln3_g, ln3_b) = w
    B, T, _ = x.shape
    x = _layer_norm(DN_ALPHA * x + 0.5 * _swiglu(x, ffn1_g, ffn1_u, ffn1_d), ln1_g, ln1_b)
    parts = _split_columns(x @ w_in)
    q = _rope(parts['q_a'].reshape(B, T, N_HEADS, HEAD_DIM), pos, ROPE_DIM).reshape(B, T, N_KV_HEADS, GROUP, HEAD_DIM)
    k = _rope(parts['k_a'].reshape(B, T, N_KV_HEADS, HEAD_DIM), pos, ROPE_DIM)
    v = parts['v_a'].reshape(B, T, N_KV_HEADS, HEAD_DIM)
    qi = _rope(parts['q_idx'].reshape(B, T, IDX_HEADS, IDX_DIM), pos, IDX_ROPE_DIM)
    ki = _rope(parts['k_idx'].reshape(B, T, 1, IDX_DIM), pos, IDX_ROPE_DIM)[:, :, 0]
    wi = parts['w_idx'] * (IDX_HEADS ** -0.5 * IDX_DIM ** -0.5)
    o_a = dsa_fn(q, k, v, qi, ki, wi).reshape(B, T, D_MODEL)
    qkv, conv_new = _causal_conv(parts['qkv_b'], conv_buf, conv_w)
    qb, kb, vb = jnp.split(qkv, [GDN_HEADS * GDN_DK, 2 * GDN_HEADS * GDN_DK], axis=-1)
    qb = _l2norm(qb.reshape(B, T, GDN_HEADS, GDN_DK)) * (GDN_DK ** -0.5)
    kb = _l2norm(kb.reshape(B, T, GDN_HEADS, GDN_DK))
    vb = vb.reshape(B, T, GDN_HEADS, GDN_DV)
    beta = jax.nn.sigmoid(parts['beta_b'].astype(jnp.float32))
    g = -jnp.exp(a_log.astype(jnp.float32)) * jax.nn.softplus(parts['a_b'].astype(jnp.float32) + dt_bias.astype(jnp.float32))
    o_b, ssm_new = _gated_delta(qb, kb, vb, g, beta, ssm0)
    z = parts['z_b'].reshape(B, T, GDN_HEADS, GDN_DV).astype(jnp.float32)
    o_b = (_rms_norm(o_b, gdn_norm_g) * jax.nn.silu(z)).reshape(B, T, D_MODEL).astype(x.dtype)
    merged = jax.nn.sigmoid(parts['gate_a']) * o_a + jax.nn.sigmoid(parts['gate_b']) * o_b
    x = _layer_norm(DN_ALPHA * x + merged @ w_o, ln2_g, ln2_b)
    x = _layer_norm(DN_ALPHA * x + 0.5 * _swiglu(x, ffn2_g, ffn2_u, ffn2_d), ln3_g, ln3_b)
    return x, (k, v, ki, ssm_new.astype(ssm0.dtype), conv_new)


def setup_inputs(seed: int = 0) -> dict:
    key = jax.random.key(seed)
    ks = iter(jax.random.split(key, 40))
    f32 = jnp.float32

    def nrm(shape, scale):
        return jax.random.normal(next(ks), shape, f32) * scale

    n_pages = PAST_LEN // PAGE_SIZE
    n_phys = (DEC_BATCH * n_pages * 5) // 4
    page_table = jax.random.permutation(next(ks), n_phys)[: DEC_BATCH * n_pages].reshape(DEC_BATCH, n_pages).astype(jnp.int32)
    dt = jnp.exp(jax.random.uniform(next(ks), (DEPTH, GDN_HEADS), f32, math.log(1e-3), math.log(1e-1)))
    a_log = jnp.log(jax.random.uniform(next(ks), (DEPTH, GDN_HEADS), f32, 1.0, 16.0))
    return {
        'x_prompt': nrm((BATCH, SEQ, D_MODEL), 1.0),
        'x_sample': nrm((DEC_BATCH, DEC_SEQ, D_MODEL), 1.0),
        'cache_k': nrm((DEPTH, n_phys, PAGE_SIZE, N_KV_HEADS, HEAD_DIM), 1.0),
        'cache_v': nrm((DEPTH, n_phys, PAGE_SIZE, N_KV_HEADS, HEAD_DIM), 1.0),
        'cache_idx_k': nrm((DEPTH, n_phys, PAGE_SIZE, IDX_DIM), 1.0),
        'state_ssm': nrm((DEPTH, DEC_BATCH, GDN_HEADS, GDN_DK, GDN_DV), 0.1),
        'state_conv': nrm((DEPTH, DEC_BATCH, CONV_W - 1, CONV_DIM), 1.0),
        'page_table': page_table,
        'ffn1_w_gate': nrm((DEPTH, D_MODEL, D_FF), D_MODEL ** -0.5),
        'ffn1_w_up': nrm((DEPTH, D_MODEL, D_FF), D_MODEL ** -0.5),
        'ffn1_w_down': nrm((DEPTH, D_FF, D_MODEL), DN_BETA * D_FF ** -0.5),
        'ln1_g': 1.0 + nrm((DEPTH, D_MODEL), 0.05),
        'ln1_b': nrm((DEPTH, D_MODEL), 0.05),
        'w_in': nrm((DEPTH, D_MODEL, IN_COLS), D_MODEL ** -0.5),
        'conv_w': nrm((DEPTH, CONV_W, CONV_DIM), CONV_W ** -0.5),
        'a_log': a_log,
        'dt_bias': jnp.log(jnp.expm1(dt)),
        'gdn_norm_g': 1.0 + nrm((DEPTH, GDN_DV), 0.05),
        'w_o': nrm((DEPTH, D_MODEL, D_MODEL), DN_BETA * D_MODEL ** -0.5),
        'ln2_g': 1.0 + nrm((DEPTH, D_MODEL), 0.05),
        'ln2_b': nrm((DEPTH, D_MODEL), 0.05),
        'ffn2_w_gate': nrm((DEPTH, D_MODEL, D_FF), D_MODEL ** -0.5),
        'ffn2_w_up': nrm((DEPTH, D_MODEL, D_FF), D_MODEL ** -0.5),
        'ffn2_w_down': nrm((DEPTH, D_FF, D_MODEL), DN_BETA * D_FF ** -0.5),
        'ln3_g': 1.0 + nrm((DEPTH, D_MODEL), 0.05),
        'ln3_b': nrm((DEPTH, D_MODEL), 0.05),
    }


def reference(x_prompt, x_sample, cache_k, cache_v, cache_idx_k, state_ssm, state_conv, page_table,
              ffn1_w_gate, ffn1_w_up, ffn1_w_down, ln1_g, ln1_b, w_in, conv_w, a_log, dt_bias,
              gdn_norm_g, w_o, ln2_g, ln2_b, ffn2_w_gate, ffn2_w_up, ffn2_w_down, ln3_g, ln3_b):
    B, S, _ = x_prompt.shape
    DB, T, _ = x_sample.shape
    pos_p = jnp.arange(S, dtype=jnp.int32)
    pos_s = PAST_LEN + jnp.arange(T, dtype=jnp.int32)
    yp, ys = x_prompt, x_sample
    outs_p, outs_s = [], []
    for l in range(DEPTH):
        w = (ffn1_w_gate[l], ffn1_w_up[l], ffn1_w_down[l], ln1_g[l], ln1_b[l], w_in[l], conv_w[l],
             a_log[l], dt_bias[l], gdn_norm_g[l], w_o[l], ln2_g[l], ln2_b[l],
             ffn2_w_gate[l], ffn2_w_up[l], ffn2_w_down[l], ln3_g[l], ln3_b[l])
        conv0 = jnp.zeros((B, CONV_W - 1, CONV_DIM), x_prompt.dtype)
        ssm0 = jnp.zeros((B, GDN_HEADS, GDN_DK, GDN_DV), state_ssm.dtype)
        yp, st_p = _layer(yp, pos_p, w, _dsa_prompt, conv0, ssm0)
        dsa_s = functools.partial(_dsa_sample, cache_k=cache_k[l], cache_v=cache_v[l],
                                  cache_ki=cache_idx_k[l], page_table=page_table)
        ys, st_s = _layer(ys, pos_s, w, dsa_s, state_conv[l], state_ssm[l])
        outs_p.append(st_p)
        outs_s.append(st_s)
    k_p, v_p, ki_p, ssm_p, conv_p = [jnp.stack(a) for a in zip(*outs_p)]
    k_s, v_s, ki_s, ssm_s, conv_s = [jnp.stack(a) for a in zip(*outs_s)]
    return (yp, ys, k_p, v_p, ki_p, ssm_p, conv_p, k_s, v_s, ki_s, ssm_s, conv_s)
```

```cpp
#include <hip/hip_runtime.h>
#include <cstdio>
#include <cstdint>
__device__ __forceinline__ int otid() { int t = (int)threadIdx.x; asm volatile("" : "+v"(t)); return t; }
namespace pg8 {
#define PG8_LAS __attribute__((address_space(3)))
typedef unsigned short bf16_t;
typedef short bf16x8 __attribute__((ext_vector_type(8)));
typedef float f32x4 __attribute__((ext_vector_type(4)));
typedef unsigned u32x4 __attribute__((ext_vector_type(4)));
constexpr int BM = 256, BK = 64, HALF = 128, HTB = HALF * BK * 2  , STAGE_BYTES = 8 * HTB, NXCD = 8, WGM = 8;

__host__ __device__ __forceinline__ int lds_byte(int r, int c) { const int st = (r >> 4) * 2 + (c >> 5), rr = r & 15, cc = c & 31, ob = rr * 64 + cc * 2; return st * 1024 + (ob ^ (((ob >> 9) & 1) << 5)); }
__host__ __device__ __forceinline__ void stage_rc(int b, int& R, int& C) { const int st = b / 1024, sb = b % 1024, swz = sb ^ (((sb >> 9) & 1) << 5); R = (st >> 1) * 16 + swz / 64; C = (st & 1) * 32 + (swz % 64) / 2; }
__host__ __device__ __forceinline__ int perm32(int rho) { const int n = rho >> 4, i = rho & 15; return 8 * (i >> 2) + 4 * n + (i & 3); }

struct Unit { int pm, pn; };
struct Gemm { const bf16_t* A; const bf16_t* Bt; int M, N, K; };

struct StaticOrder {
    int nM, nN, nwg, G, c;
    __host__ __device__ void init(int M, int N, int G_, int c_) { nM = M / BM; nN = N / BM; nwg = nM * nN; G = G_; c = c_; }
    __host__ __device__ bool next(int i, Unit& u) const {
        const long L = (long)i * G + c; if (L >= nwg) return false;
        int wgid = (int)L; { const int q = nwg / NXCD, r = nwg % NXCD, xcd = wgid % NXCD, off = wgid / NXCD; wgid = (xcd < r ? xcd * (q + 1) : r * (q + 1) + (xcd - r) * q) + off; }
        const int nig = WGM * nN, gid = wgid / nig, fm = gid * WGM, gsz = (nM - fm) < WGM ? (nM - fm) : WGM;
        u.pm = fm + ((wgid % nig) % gsz); u.pn = (wgid % nig) / gsz; return true;
    }
    __device__ __forceinline__ void a_ready(const Unit&) const {}
    __device__ __forceinline__ void done(const Unit&) const {}
};

__device__ __forceinline__ unsigned cvt_pk_bf16(float lo, float hi) { unsigned r; asm volatile("v_cvt_pk_bf16_f32 %0, %1, %2" : "=v"(r) : "v"(lo), "v"(hi)); return r; }
template <class Epi, class Sched, bool ALIGN_EPI = false, bool SP2 = false>
__device__ __forceinline__ void gemm_phase(PG8_LAS unsigned char* lds, const Gemm g, const Sched& S, const Epi& E) {
    const int tid = otid(), wid = __builtin_amdgcn_readfirstlane(tid >> 6), lane = tid & 63, wr = wid >> 2, wc = wid & 3, fr = lane & 15, fq = lane >> 4;
    const int K = g.K, nt = K / BK;
    unsigned voffA[2], voffB[2];
#pragma unroll
    for (int i = 0; i < 2; ++i) { int R, C; stage_rc(tid * 16 + i * 8192, R, C); const int Rb = Epi::PERM ? ((R & ~31) + perm32(R & 31)) : R;
        voffA[i] = (unsigned)(R * K + C) * 2u; voffB[i] = (unsigned)(Rb * K + C) * 2u; }
    const size_t kstep = (size_t)(BK * 2);
    const size_t hstep = (size_t)HALF * K * 2;
    const size_t tstep = 2 * hstep;
    const unsigned ldsw = (unsigned)wid * 1024u;
    const int aoff = lds_byte(wr * 64 + fr, fq * 8), boff = lds_byte(wc * 32 + fr, fq * 8);
#define PG8_SA(b, h) (((b) * 2 + (h)) * HTB)
#define PG8_SB(b, h) ((4 + (b) * 2 + (h)) * HTB)
#define PG8_STAGE(bufoff, gbase, voff) do { _Pragma("unroll") for (int _i = 0; _i < 2; ++_i) \
        __builtin_amdgcn_global_load_lds((const unsigned*)((const char*)(gbase) + (voff)[_i]), (PG8_LAS unsigned*)(lds + (bufoff) + ldsw + _i * 8192), 16, 0, 0); } while (0)
#define PG8_LDA(dst, b, h) do { _Pragma("unroll") for (int m = 0; m < 4; ++m) _Pragma("unroll") for (int k = 0; k < 2; ++k) dst[m][k] = *(const PG8_LAS bf16x8*)(lds + PG8_SA(b, h) + aoff + m * 2048 + k * 1024); } while (0)
#define PG8_LDB(dst, b, h) do { _Pragma("unroll") for (int n = 0; n < 2; ++n) _Pragma("unroll") for (int k = 0; k < 2; ++k) dst[n][k] = *(const PG8_LAS bf16x8*)(lds + PG8_SB(b, h) + boff + n * 2048 + k * 1024); } while (0)
#define PG8_MMA(ai, bj, At, Bt) do { __builtin_amdgcn_s_setprio(1); _Pragma("unroll") for (int m = 0; m < 4; ++m) _Pragma("unroll") for (int n = 0; n < 2; ++n) _Pragma("unroll") for (int k = 0; k < 2; ++k) \
        acc[ai][bj][m][n] = __builtin_amdgcn_mfma_f32_16x16x32_bf16(Bt[n][k], At[m][k], acc[ai][bj][m][n], 0, 0, 0); __builtin_amdgcn_s_setprio(0); } while (0)
#define PG8_WAIT_V(n) asm volatile("s_waitcnt vmcnt(" #n ")" ::: "memory")
#define PG8_WAIT_L(n) asm volatile("s_waitcnt lgkmcnt(" #n ")" ::: "memory")
#define PG8_BAR __builtin_amdgcn_s_barrier()
#define PG8_SCHED __builtin_amdgcn_sched_barrier(0)
    Unit cur, nxt; int ui = 0;
    if (!S.next(0, cur)) return;
    f32x4 acc[2][2][4][2];
#pragma unroll
    for (int a = 0; a < 2; ++a)
#pragma unroll
        for (int b = 0; b < 2; ++b)
#pragma unroll
            for (int m = 0; m < 4; ++m)
#pragma unroll
                for (int n = 0; n < 2; ++n) acc[a][b][m][n] = (f32x4){0.f, 0.f, 0.f, 0.f};
    bf16x8 At[4][2], B0[2][2], B1[2][2];
    const char* cA = (const char*)g.A + (size_t)cur.pm * tstep; const char* cB = (const char*)g.Bt + (size_t)cur.pn * tstep;
    S.a_ready(cur);
    if constexpr (SP2) {
        PG8_STAGE(PG8_SB(0, 0), cB, voffB); PG8_STAGE(PG8_SB(0, 1), cB + hstep, voffB); PG8_STAGE(PG8_SA(0, 0), cA, voffA); PG8_STAGE(PG8_SA(0, 1), cA + hstep, voffA);
        if (wr == 1) PG8_BAR;
        PG8_WAIT_V(2); PG8_BAR;
        PG8_STAGE(PG8_SB(1, 0), cB + kstep, voffB); PG8_STAGE(PG8_SA(1, 0), cA + kstep, voffA); PG8_STAGE(PG8_SB(1, 1), cB + hstep + kstep, voffB);
        PG8_WAIT_V(6); PG8_BAR;
    } else {
        PG8_STAGE(PG8_SB(0, 0), cB, voffB); PG8_STAGE(PG8_SA(0, 0), cA, voffA); PG8_STAGE(PG8_SB(0, 1), cB + hstep, voffB); PG8_STAGE(PG8_SA(0, 1), cA + hstep, voffA);
        if (wr == 1) PG8_BAR;
        PG8_WAIT_V(4); PG8_BAR;
        PG8_STAGE(PG8_SB(1, 0), cB + kstep, voffB); PG8_STAGE(PG8_SA(1, 0), cA + kstep, voffA); PG8_STAGE(PG8_SB(1, 1), cB + hstep + kstep, voffB);
        PG8_WAIT_V(6); PG8_BAR;
    }
    for (;;) {
        const bool has_next = S.next(ui + 1, nxt);
        if constexpr (Epi::PF) {
            PG8_LAS unsigned char* ops = lds + STAGE_BYTES + (ui & 1) * 4096;
            const unsigned ln_ = __builtin_amdgcn_mbcnt_hi(~0u, __builtin_amdgcn_mbcnt_lo(~0u, 0u));
            __builtin_amdgcn_global_load_lds((const unsigned*)(E.pf_stats() + (size_t)cur.pm * 512 + wid * 64) + ln_, (PG8_LAS unsigned*)(ops + wid * 256), 4, 0, 0);
            __builtin_amdgcn_global_load_lds((const unsigned*)((wid < 4 ? E.pf_vec0() : E.pf_vec1()) + (size_t)cur.pn * 256 + (wid & 3) * 64) + ln_, (PG8_LAS unsigned*)(ops + 2048 + wid * 256), 4, 0, 0);
        }
        const char* nA = has_next ? (const char*)g.A + (size_t)nxt.pm * tstep : cA; const char* nB = has_next ? (const char*)g.Bt + (size_t)nxt.pn * tstep : cB;
        for (int t = 0; t < nt; t += 2) {
            const bool last = (t == nt - 2);
            const char* a1 = cA + (size_t)(t + 1) * kstep;
            const char* a2 = last ? nA : cA + (size_t)(t + 2) * kstep; const char* b2 = last ? nB : cB + (size_t)(t + 2) * kstep;
            const char* a3 = a2 + kstep; const char* b3 = b2 + kstep;
            if (last && has_next) S.a_ready(nxt);
            if constexpr (SP2) {
            PG8_LDB(B0, 0, 0); PG8_LDB(B1, 0, 1); PG8_SCHED; PG8_LDA(At, 0, 0); PG8_STAGE(PG8_SA(1, 1), a1 + hstep, voffA);
            PG8_WAIT_V(8); PG8_WAIT_L(0); PG8_BAR; PG8_MMA(0, 0, At, B0); PG8_MMA(0, 1, At, B1); PG8_BAR; PG8_SCHED;
            PG8_LDA(At, 0, 1); PG8_STAGE(PG8_SB(0, 0), b2, voffB); PG8_STAGE(PG8_SB(0, 1), b2 + hstep, voffB); PG8_STAGE(PG8_SA(0, 0), a2, voffA);
            PG8_WAIT_V(8); PG8_WAIT_L(0); PG8_BAR; PG8_MMA(1, 0, At, B0); PG8_MMA(1, 1, At, B1); PG8_BAR; PG8_SCHED;
            PG8_LDB(B0, 1, 0); PG8_LDB(B1, 1, 1); PG8_SCHED; PG8_LDA(At, 1, 0); PG8_STAGE(PG8_SA(0, 1), a2 + hstep, voffA);
            PG8_WAIT_V(8); PG8_WAIT_L(0); PG8_BAR; PG8_MMA(0, 0, At, B0); PG8_MMA(0, 1, At, B1); PG8_BAR; PG8_SCHED;
            PG8_LDA(At, 1, 1); PG8_STAGE(PG8_SB(1, 0), b3, voffB); PG8_STAGE(PG8_SB(1, 1), b3 + hstep, voffB); PG8_STAGE(PG8_SA(1, 0), a3, voffA);
            PG8_WAIT_V(8); PG8_WAIT_L(0); PG8_BAR; PG8_MMA(1, 0, At, B0); PG8_MMA(1, 1, At, B1); PG8_BAR; PG8_SCHED;
            } else {
            PG8_LDB(B0, 0, 0); PG8_SCHED; PG8_LDA(At, 0, 0); PG8_STAGE(PG8_SA(1, 1), a1 + hstep, voffA);
            PG8_WAIT_L(8); PG8_BAR; PG8_WAIT_L(0); PG8_MMA(0, 0, At, B0); PG8_BAR; PG8_SCHED;
            PG8_LDB(B1, 0, 1); PG8_STAGE(PG8_SB(0, 0), b2, voffB);
            PG8_BAR; PG8_WAIT_L(0); PG8_MMA(0, 1, At, B1); PG8_BAR;
            PG8_LDA(At, 0, 1); PG8_STAGE(PG8_SA(0, 0), a2, voffA);
            PG8_BAR; PG8_WAIT_L(0); PG8_MMA(1, 0, At, B0); PG8_BAR; PG8_SCHED;
            PG8_STAGE(PG8_SB(0, 1), b2 + hstep, voffB);
            PG8_WAIT_V(6); PG8_BAR; PG8_MMA(1, 1, At, B1); PG8_BAR;
            PG8_LDB(B0, 1, 0); PG8_SCHED; PG8_LDA(At, 1, 0); PG8_STAGE(PG8_SA(0, 1), a2 + hstep, voffA);
            PG8_WAIT_L(8); PG8_BAR; PG8_WAIT_L(0); PG8_MMA(0, 0, At, B0); PG8_BAR; PG8_SCHED;
            PG8_LDB(B1, 1, 1); PG8_STAGE(PG8_SB(1, 0), b3, voffB);
            PG8_BAR; PG8_WAIT_L(0); PG8_MMA(0, 1, At, B1); PG8_BAR;
            PG8_LDA(At, 1, 1); PG8_STAGE(PG8_SA(1, 0), a3, voffA);
            PG8_BAR; PG8_WAIT_L(0); PG8_MMA(1, 0, At, B0); PG8_BAR; PG8_SCHED;
            PG8_STAGE(PG8_SB(1, 1), b3 + hstep, voffB);
            PG8_WAIT_V(6); PG8_BAR; PG8_MMA(1, 1, At, B1); PG8_BAR;
            }
        }
        if constexpr (ALIGN_EPI) { if (wr == 0) PG8_BAR; }
        if constexpr (!Epi::AFTER_DRAIN) { E(acc, cur, wr, wc, fr, fq, lds + STAGE_BYTES + (ui & 1) * 4096); S.done(cur); }
        if (!has_next) break;
#pragma unroll
        for (int a = 0; a < 2; ++a)
#pragma unroll
            for (int b = 0; b < 2; ++b)
#pragma unroll
                for (int m = 0; m < 4; ++m)
#pragma unroll
                    for (int n = 0; n < 2; ++n) acc[a][b][m][n] = (f32x4){0.f, 0.f, 0.f, 0.f};
        cur = nxt; cA = nA; cB = nB; ++ui;
        if constexpr (ALIGN_EPI) { if (wr == 1) PG8_BAR; }
    }
    PG8_WAIT_V(0);
    if constexpr (!ALIGN_EPI) { if (wr == 0) PG8_BAR; }
    PG8_BAR;
    if constexpr (Epi::AFTER_DRAIN) { E.fused(acc, cur, wr, wc, fr, fq, lds, wid, lane); S.done(cur); }
#undef PG8_SA
#undef PG8_SB
#undef PG8_STAGE
#undef PG8_LDA
#undef PG8_LDB
#undef PG8_MMA
#undef PG8_WAIT_V
#undef PG8_WAIT_L
#undef PG8_BAR
#undef PG8_SCHED
}
}

#define GAS __attribute__((address_space(1)))
#define LAS __attribute__((address_space(3)))
typedef unsigned short bf16;
typedef float f32x2 __attribute__((ext_vector_type(2)));
typedef float f32x4 __attribute__((ext_vector_type(4)));
typedef float f32x16 __attribute__((ext_vector_type(16)));
typedef short bf16x8 __attribute__((ext_vector_type(8)));
typedef short s16x4 __attribute__((ext_vector_type(4)));
typedef unsigned u32x2 __attribute__((ext_vector_type(2)));
typedef unsigned u32x4 __attribute__((ext_vector_type(4)));

constexpr int DM = 2048, SEQ = 2048, MP = 8192, MROWS = 8200, MPAD = 8448;
constexpr int DFF = 5632, NFF2 = 11264, NIN = 16640, INCOLS = 16496;
constexpr int PAST = 16384, NPAGES = 128;
constexpr int CONVD = 6144;
constexpr float DN_ALPHA = 1.189207115002721f;
constexpr float QSCALE = 0.08838834764831845f * 1.4426950408889634f;
constexpr float LOG2E = 1.4426950408889634f;

constexpr size_t O_YP = 0, O_YS = 16777216, O_KP = 16793600, O_VP = 20987904, O_IKP = 25182208, O_SSMP = 25706496, O_CONVP = 26755072,
                 O_KS = 26828800, O_VS = 26832896, O_IKS = 26836992, O_SSMS = 26837504, O_CONVS = 28934656, O_END = 29082112;

constexpr size_t al256(size_t x) { return (x + 255) & ~(size_t)255; }
constexpr size_t WS_CTL = 0, CTL_BYTES = 1u << 20;
constexpr size_t WS_ROPEA = CTL_BYTES;
constexpr size_t WS_ROPEI = WS_ROPEA + al256(2049 * 16 * 8);
constexpr size_t WS_W1T = WS_ROPEI + al256(2049 * 8 * 8);
constexpr size_t WS_W1D = WS_W1T + (size_t)NFF2 * DM * 2;
constexpr size_t WS_WIN = WS_W1D + (size_t)DM * DFF * 2;
constexpr size_t WS_WO = WS_WIN + (size_t)NIN * DM * 2;
constexpr size_t WS_W2T = WS_WO + (size_t)DM * DM * 2;
constexpr size_t WS_W2D = WS_W2T + (size_t)NFF2 * DM * 2;
constexpr size_t WS_XB = WS_W2D + (size_t)DM * DFF * 2;
constexpr size_t WS_H = WS_XB + (size_t)MPAD * DM * 2;
constexpr size_t WS_PRE = WS_H + (size_t)MPAD * DFF * 2;
constexpr size_t WS_X1 = WS_PRE + (size_t)MPAD * DM * 4;
constexpr size_t WS_X1B = WS_X1 + (size_t)MPAD * DM * 4;
constexpr size_t WS_Q = WS_X1B + (size_t)MPAD * DM * 2;
constexpr size_t WS_KB = WS_Q + (size_t)MPAD * DM * 2;
constexpr size_t WS_VB = WS_KB + (size_t)MPAD * 512 * 2;
constexpr size_t WS_QI = WS_VB + (size_t)MPAD * 512 * 2;
constexpr size_t WS_KI = WS_QI + (size_t)MPAD * 1024 * 2;
constexpr size_t WS_QIS = WS_KI + (size_t)MPAD * 64 * 2;
constexpr size_t WS_WIDX = WS_QIS + 8 * 1024 * 4;
constexpr size_t WS_GDEC = WS_WIDX + (size_t)MPAD * 16 * 4;
constexpr size_t WS_BETA = WS_GDEC + (size_t)MPAD * 16 * 4;
constexpr size_t WS_RAW = WS_BETA + (size_t)MPAD * 16 * 4;
constexpr size_t WS_ZS = WS_RAW + (size_t)MPAD * CONVD * 2;
constexpr size_t WS_GA = WS_ZS + (size_t)MPAD * DM * 2;
constexpr size_t WS_GB = WS_GA + (size_t)MPAD * DM * 2;
constexpr size_t WS_QH = WS_GB + (size_t)MPAD * DM * 2;
constexpr size_t WS_KH = WS_QH + (size_t)MPAD * DM * 2;
constexpr size_t WS_VH = WS_KH + (size_t)MPAD * DM * 2;
constexpr size_t WS_SC = WS_VH + (size_t)MPAD * DM * 2;
constexpr size_t WS_MASK = WS_SC + (size_t)MP * SEQ * 4;
constexpr size_t WS_SCS = WS_MASK + (size_t)MP * 64 * 4;
constexpr size_t WS_SELS = WS_SCS + 8 * 16640 * 4;
constexpr size_t WS_OA = WS_SELS + 32 * 256 * 4;
constexpr size_t WS_OB = WS_OA + (size_t)MPAD * DM * 2;
constexpr size_t WS_MRG = WS_OB + (size_t)MPAD * DM * 4;
constexpr size_t WS_END = WS_MRG + (size_t)MPAD * DM * 2;

constexpr size_t CW_ST1 = 0x10000, CW_ST2 = 0x21000;
constexpr size_t CW_CSIN = 0x32000, CW_BBIN = 0x43000;
constexpr size_t CW_CSGU = 0x54000, CW_BBGU = 0x60000;
constexpr size_t CW_ST3 = 0x70000, CW_PCNT = 0x81000;
constexpr size_t CW_GDNA = 0x6C000;
constexpr int LDS_BYTES = 163840;
constexpr int LDS_MISC = 159744;

struct P {
    const float *x_prompt, *x_sample, *cache_k, *cache_v, *cache_ik, *state_ssm, *state_conv; const int* page_table;
    const float *w1g, *w1u, *w1d, *ln1g, *ln1b, *win, *convw, *alog, *dtb, *gng, *wo, *ln2g, *ln2b, *w2g, *w2u, *w2d, *ln3g, *ln3b;
    float* out; unsigned char* ws;
};

typedef __bf16 bf16x2_t __attribute__((ext_vector_type(2)));
__device__ __forceinline__ unsigned pkbf(float lo, float hi) { const f32x2 v = {lo, hi}; const bf16x2_t b = __builtin_convertvector(v, bf16x2_t); return __builtin_bit_cast(unsigned, b); }
__device__ __forceinline__ float bf2f(unsigned short b) { return __builtin_bit_cast(float, (unsigned)b << 16); }
__device__ __forceinline__ float bflo(unsigned w) { return __builtin_bit_cast(float, w << 16); }
__device__ __forceinline__ float bfhi(unsigned w) { return __builtin_bit_cast(float, w & 0xffff0000u); }
__device__ __forceinline__ u32x2 pk4(f32x4 v) { u32x2 r; r.x = pkbf(v[0], v[1]); r.y = pkbf(v[2], v[3]); return r; }
__device__ __forceinline__ f32x4 unpk4(u32x2 w) { return (f32x4){bflo(w.x), bfhi(w.x), bflo(w.y), bfhi(w.y)}; }
__device__ __forceinline__ float fexp2(float x) { return __builtin_amdgcn_exp2f(x); }
__device__ __forceinline__ float frcp(float x) { return __builtin_amdgcn_rcpf(x); }
__device__ __forceinline__ float sigmoidf_(float x) { return frcp(1.f + fexp2(-x * LOG2E)); }
__device__ __forceinline__ float siluf_(float x) { return x * sigmoidf_(x); }
__device__ __forceinline__ f32x4 silu4(f32x4 v) { return (f32x4){siluf_(v[0]), siluf_(v[1]), siluf_(v[2]), siluf_(v[3])}; }
__device__ __forceinline__ f32x4 sigm4(f32x4 v) { return (f32x4){sigmoidf_(v[0]), sigmoidf_(v[1]), sigmoidf_(v[2]), sigmoidf_(v[3])}; }
__device__ __forceinline__ float fmax_fast(float a, float b) { return __builtin_amdgcn_fmed3f(a, b, __builtin_inff()); }
__device__ __forceinline__ float relu_fast(float a) { return __builtin_amdgcn_fmed3f(a, 0.f, __builtin_inff()); }
#define LDS_WAIT() asm volatile("s_waitcnt lgkmcnt(0)" ::: "memory")
__device__ __forceinline__ void lds_barrier() { asm volatile("s_waitcnt lgkmcnt(0)" ::: "memory"); __builtin_amdgcn_s_barrier(); asm volatile("" ::: "memory"); }
#define VM_WAIT() asm volatile("s_waitcnt vmcnt(0)" ::: "memory")

__device__ __forceinline__ void tr_item(const float* src, int srcN, int c0, int c1, bool v0, bool v1, int K, bf16* dst, int dst_r0, int k0, LAS float* scr, int lane,
                                        const float* lng, const float* lnb, float* cs, float* bb) {
    const int c = lane & 31; const bool ok = (c < 16) ? v0 : v1; const int sc = (c < 16) ? (c0 + c) : (c1 + c - 16);
    float bsum = 0.f;
#pragma unroll 8
    for (int i = 0; i < 32; ++i) { const int kk = 2 * i + (lane >> 5); float w = ok ? src[(size_t)(k0 + kk) * srcN + sc] : 0.f;
        if (lng) { bsum += lnb[k0 + kk] * w; w *= lng[k0 + kk]; }
        scr[kk * 33 + c] = w; }
    if (lng) { bsum += __shfl_xor(bsum, 32); if (lane < 32) atomicAdd(bb + dst_r0 + c, bsum); }
    LDS_WAIT(); asm volatile("" ::: "memory");
    const int c8 = lane & 7;
#pragma unroll
    for (int j = 0; j < 4; ++j) { const int n = (lane >> 3) + 8 * j; const LAS float* s = scr + (8 * c8) * 33 + n;
        u32x4 o; o.x = pkbf(s[0 * 33], s[1 * 33]); o.y = pkbf(s[2 * 33], s[3 * 33]); o.z = pkbf(s[4 * 33], s[5 * 33]); o.w = pkbf(s[6 * 33], s[7 * 33]);
        *(u32x4*)(dst + (size_t)(dst_r0 + n) * K + k0 + 8 * c8) = o;
        if (lng) { float q = ((bflo(o.x) + bfhi(o.x)) + (bflo(o.y) + bfhi(o.y))) + ((bflo(o.z) + bfhi(o.z)) + (bflo(o.w) + bfhi(o.w)));
            q += __shfl_xor(q, 1); q += __shfl_xor(q, 2); q += __shfl_xor(q, 4); if (c8 == 0) atomicAdd(cs + dst_r0 + n, q); } }
    LDS_WAIT(); asm volatile("" ::: "memory");
}

__device__ __forceinline__ void tr_item64(const float* src, int srcN, int sc0, int K, bf16* dst, int dst_r0, int k0, int lane,
                                          const float* lng, const float* lnb, float* cs, float* bb, int permmask = 0) {
    const int kq = lane >> 4, c = lane & 15;
    const int rb4 = ((permmask >> (c >> 3)) & 1) ? 32 * (c >> 3) + 16 * (c & 1) + 4 * ((c & 7) >> 1) : 4 * c;
    const float* sp = src + (size_t)(k0 + 16 * kq) * srcN + sc0 + 4 * c;
    f32x4 v[16];
#pragma unroll
    for (int i = 0; i < 16; ++i) v[i] = __builtin_nontemporal_load((const f32x4*)(sp + (size_t)i * srcN));
    if (lng) {
        f32x4 bs = {0.f, 0.f, 0.f, 0.f};
#pragma unroll
        for (int q = 0; q < 4; ++q) { const f32x4 gq = *(const f32x4*)(lng + k0 + 16 * kq + 4 * q), bq = *(const f32x4*)(lnb + k0 + 16 * kq + 4 * q);
#pragma unroll
            for (int e = 0; e < 4; ++e) { bs += v[4 * q + e] * bq[e]; v[4 * q + e] = v[4 * q + e] * gq[e]; } }
#pragma unroll
        for (int j = 0; j < 4; ++j) { float t = bs[j]; t += __shfl_xor(t, 16); t += __shfl_xor(t, 32); if (kq == 0) atomicAdd(bb + dst_r0 + rb4 + j, t); }
    }
    bf16* dp = dst + (size_t)(dst_r0 + rb4) * K + k0 + 16 * kq;
#pragma unroll
    for (int j = 0; j < 4; ++j) {
        u32x4 w0, w1;
        w0.x = pkbf(v[0][j], v[1][j]); w0.y = pkbf(v[2][j], v[3][j]); w0.z = pkbf(v[4][j], v[5][j]); w0.w = pkbf(v[6][j], v[7][j]);
        w1.x = pkbf(v[8][j], v[9][j]); w1.y = pkbf(v[10][j], v[11][j]); w1.z = pkbf(v[12][j], v[13][j]); w1.w = pkbf(v[14][j], v[15][j]);
        *(u32x4*)(dp + (size_t)j * K) = w0; *(u32x4*)(dp + (size_t)j * K + 8) = w1;
        if (lng) { float q = (((bflo(w0.x) + bfhi(w0.x)) + (bflo(w0.y) + bfhi(w0.y))) + ((bflo(w0.z) + bfhi(w0.z)) + (bflo(w0.w) + bfhi(w0.w))))
                           + (((bflo(w1.x) + bfhi(w1.x)) + (bflo(w1.y) + bfhi(w1.y))) + ((bflo(w1.z) + bfhi(w1.z)) + (bflo(w1.w) + bfhi(w1.w))));
            q += __shfl_xor(q, 16); q += __shfl_xor(q, 32); if (kq == 0) atomicAdd(cs + dst_r0 + rb4 + j, q); }
    }
}

__device__ __forceinline__ void sincos_d(float ang, float& s_out, float& c_out) {
    const double x = (double)ang;
    const double n = __builtin_rint(x * 0.63661977236758134308);
    double r = x - n * 1.57079632673412561417e+00; r = r - n * 6.07710050650619224932e-11;
    const double r2 = r * r;
    double sp = -7.6471637318198164759e-13; sp = sp * r2 + 1.6059043836821614599e-10; sp = sp * r2 - 2.5052108385441718775e-08; sp = sp * r2 + 2.7557319223985890653e-06;
    sp = sp * r2 - 1.9841269841269841270e-04; sp = sp * r2 + 8.3333333333333333333e-03; sp = sp * r2 - 1.6666666666666666667e-01; const double sn = r + r * r2 * sp;
    double cp = 4.7794773323873852974e-14; cp = cp * r2 - 1.1470745597729724714e-11; cp = cp * r2 + 2.0876756987868098979e-09; cp = cp * r2 - 2.7557319223985890653e-07;
    cp = cp * r2 + 2.4801587301587301587e-05; cp = cp * r2 - 1.3888888888888888889e-03; cp = cp * r2 + 4.1666666666666666667e-02; cp = cp * r2 - 0.5; const double cs = 1.0 + r2 * cp;
    const int q = ((int)n) & 3;
    const double s = (q == 0) ? sn : (q == 1) ? cs : (q == 2) ? -sn : -cs;
    const double c = (q == 0) ? cs : (q == 1) ? -sn : (q == 2) ? -cs : sn;
    s_out = (float)s; c_out = (float)c;
}

__device__ __forceinline__ void convert_ffn2(const P& p, int gwi, int ngw, int lane) {
    bf16* W2T = (bf16*)(p.ws + WS_W2T); bf16* W2D = (bf16*)(p.ws + WS_W2D);
    constexpr int I_GU = 32 * 176, I_D = 88 * 32;
    for (int it = gwi; it < I_GU + I_D; it += ngw) {
        if (it < I_GU) { const int kb = it / 176, nb = it % 176, tile = nb >> 2, blk = nb & 3;
            tr_item64(blk < 2 ? p.w2g : p.w2u, DFF, tile * 128 + (blk & 1) * 64, DM, W2T, nb * 64, kb * 64, lane, p.ln2g, p.ln2b, (float*)(p.ws + CW_CSGU), (float*)(p.ws + CW_BBGU)); }
        else { const int r = it - I_GU, kb = r / 32, nb = r % 32; tr_item64(p.w2d, DM, nb * 64, DFF, W2D, nb * 64, kb * 64, lane, nullptr, nullptr, nullptr, nullptr); }
    }
}

__device__ __forceinline__ void p0_prologue(const P& p, LAS unsigned char* lds) {
    const int tid = otid(), lane = tid & 63, wid = tid >> 6;
    const int gw = blockIdx.x * 8 + wid, NGW = gridDim.x * 8;
    LAS float* scr = (LAS float*)(lds + wid * 8448);
    bf16* W1T = (bf16*)(p.ws + WS_W1T); bf16* W1D = (bf16*)(p.ws + WS_W1D); bf16* WIN = (bf16*)(p.ws + WS_WIN); bf16* WO = (bf16*)(p.ws + WS_WO);
    constexpr int I_GU = 32 * 176, I_D = 88 * 32, I_O = 32 * 32, I_IN = 32 * 256, I_SM = 32 * 8;
    constexpr int NITEMS = I_GU + I_D + I_O + I_IN + I_SM;
    for (int it = gw; it < NITEMS; it += NGW) {
        int r = it;
        if (r < I_GU) {
            const int kb = r / 176, nb = r % 176, tile = nb >> 2, blk = nb & 3;
            tr_item64(blk < 2 ? p.w1g : p.w1u, DFF, tile * 128 + (blk & 1) * 64, DM, W1T, nb * 64, kb * 64, lane, nullptr, nullptr, nullptr, nullptr); continue; }
        r -= I_GU;
        if (r < I_D) { const int kb = r / 32, nb = r % 32;
            tr_item64(p.w1d, DM, nb * 64, DFF, W1D, nb * 64, kb * 64, lane, nullptr, nullptr, nullptr, nullptr, 3); continue; }
        r -= I_D;
        if (r < I_O) { const int kb = r / 32, nb = r % 32; tr_item64(p.wo, DM, nb * 64, DM, WO, nb * 64, kb * 64, lane, nullptr, nullptr, nullptr, nullptr, 3); continue; }
        r -= I_O;
        if (r < I_IN) { const int kb = r / 256, nb = r % 256;
            const int sc = nb < 64 ? nb * 64 : nb < 160 ? 4176 + (nb - 64) * 64 : 10352 + (nb - 160) * 64;
            const int pn_ = nb >> 2, g8 = (nb & 3) * 2; int pm_ = 0;
#pragma unroll
            for (int hh = 0; hh < 2; ++hh) { const int wc_ = (g8 + hh) & 3; const bool nat = (pn_ < 10 && wc_ == 0) || (pn_ >= 12 && pn_ < 16 && (wc_ & 1) == 0); pm_ |= nat ? 0 : (1 << hh); }
            tr_item64(p.win, INCOLS, sc, DM, WIN, nb * 64, kb * 64, lane, p.ln1g, p.ln1b, (float*)(p.ws + CW_CSIN), (float*)(p.ws + CW_BBIN), pm_); continue; }
        r -= I_IN;
        {   const int kb = r / 8, nb = 512 + (r % 8); int c0, c1; bool v0 = true, v1 = true;
            if (nb < 514) { c0 = 4096 + (nb - 512) * 32; c1 = c0 + 16; }
            else if (nb == 514) { c0 = 4160; c1 = 10320; }
            else if (nb == 515) { c0 = 10336; c1 = 0; v1 = false; }
            else { c0 = 0; c1 = 0; v0 = false; v1 = false; }
            tr_item(p.win, INCOLS, c0, c1, v0, v1, DM, WIN, nb * 32, kb * 64, scr, lane, p.ln1g, p.ln1b, (float*)(p.ws + CW_CSIN), (float*)(p.ws + CW_BBIN)); }
    }
    bf16* XB = (bf16*)(p.ws + WS_XB);
    for (int row = gw; row < MROWS; row += NGW) {
        const float* xr = row < MP ? p.x_prompt + (size_t)row * DM : p.x_sample + (size_t)(row - MP) * DM;
#pragma unroll
        for (int j = 0; j < 8; ++j) { const f32x4 v = *(const f32x4*)(xr + j * 256 + lane * 4); *(u32x2*)(XB + (size_t)row * DM + j * 256 + lane * 4) = pk4(v); }
    }
    {   const float invA[16] = {1.000000000e+00f, 4.403665960e-01f, 1.939227432e-01f, 8.539710194e-02f, 3.760603070e-02f, 1.656043902e-02f, 7.292664610e-03f, 3.211445874e-03f,
                                1.414213562e-03f, 6.227723788e-04f, 2.742481884e-04f, 1.207697351e-04f, 5.318296098e-05f, 2.341999971e-05f, 1.031338616e-05f, 4.541670478e-06f};
        f32x2* RA = (f32x2*)(p.ws + WS_ROPEA); f32x2* RI = (f32x2*)(p.ws + WS_ROPEI);
        const int gt = blockIdx.x * 512 + tid, NT = gridDim.x * 512;
        for (int e = gt; e < 2049 * 16; e += NT) { const int pi = e >> 4, i = e & 15; const float pos = pi < 2048 ? (float)pi : 16384.f;
            float iv = invA[0];
#pragma unroll
            for (int k = 1; k < 16; ++k) iv = (i == k) ? invA[k] : iv;
            const float ang = pos * iv; float s, c; sincos_d(ang, s, c); RA[e] = (f32x2){c, s};
            if ((i & 1) == 0) { RI[pi * 8 + (i >> 1)] = (f32x2){c, s}; } }
        if (gt < 16) { float* ga = (float*)(p.ws + CW_GDNA); ga[gt] = -__expf(p.alog[gt]); ga[16 + gt] = p.dtb[gt]; }
        for (int e = gt; e < 8 * 2 * CONVD; e += NT) { const int d = e / (2 * CONVD), rem = e % (2 * CONVD);
            p.out[O_CONVS + (size_t)d * 3 * CONVD + rem] = p.state_conv[(size_t)d * 3 * CONVD + CONVD + rem]; }
    }
}
#define XB_TMO      128
#define XB_XCNT(j)  (256  + 64 * (j))
#define XB_XSUB(j)  (1280 + 64 * (j))
#define XB_XGEN(j)  (2304 + 64 * (j))
#define XB_TOP      3328
#define XB_TOPGEN   3392
#define XCD_BAR_WORDS 3456
#define XB_SPIN_CAP (1u << 18)

__device__ __forceinline__ unsigned xb_ld(unsigned* p)              { return __hip_atomic_load(p, __ATOMIC_RELAXED, __HIP_MEMORY_SCOPE_AGENT); }
__device__ __forceinline__ unsigned xb_add(unsigned* p, unsigned v) { return __hip_atomic_fetch_add(p, v, __ATOMIC_RELAXED, __HIP_MEMORY_SCOPE_AGENT); }
__device__ __forceinline__ unsigned xb_xcc_id() { return (unsigned)__builtin_amdgcn_s_getreg((3 << 11) | 20) & 0xFu; }
#define XB_SPIN(cond, bar) do { unsigned _sp = 0; while (cond) { __builtin_amdgcn_s_sleep(1); \
    if ((++_sp & 255u) == 0u) { if (xb_ld(&(bar)[XB_TMO])) break; if (_sp > XB_SPIN_CAP) { atomicAdd(&(bar)[XB_TMO], 1u); break; } } } } while (0)

struct XcdBarrier {
    unsigned* bar; unsigned x;
    volatile LAS unsigned* st;
};

__device__ __forceinline__ XcdBarrier xcd_barrier_post(unsigned* bar, volatile LAS unsigned* st) {
    XcdBarrier b; b.bar = bar; b.x = xb_xcc_id(); b.st = st;
    if (threadIdx.x == 0) (void)xb_add(&bar[XB_XCNT(b.x)], 1u);
    return b;
}
__device__ __forceinline__ void xcd_barrier_complete(unsigned* bar, unsigned x, unsigned& nloc, unsigned& nx) {
    const unsigned G = gridDim.x * gridDim.y * gridDim.z;
    unsigned sum, cnt, mine, sp = 0u;
    for (;;) {
        sum = 0u; cnt = 0u; mine = 0u;
#pragma unroll
        for (unsigned j = 0; j < 16; ++j) { const unsigned c = xb_ld(&bar[XB_XCNT(j)]); sum += c; cnt += (c > 0u) ? 1u : 0u; mine = (j == x) ? c : mine; }
        if (sum == G) break;
        __builtin_amdgcn_s_sleep(1);
        if ((++sp & 255u) == 0u) { if (xb_ld(&bar[XB_TMO])) break; if (sp > XB_SPIN_CAP) { atomicAdd(&bar[XB_TMO], 1u); break; } }
    }
    nloc = mine > 0u ? mine : 1u; nx = cnt > 0u ? cnt : 1u;
}

__device__ __forceinline__ void xcd_barrier(const XcdBarrier& b) {
    asm volatile("s_waitcnt vmcnt(0)" ::: "memory");
    __syncthreads();
    if (threadIdx.x == 0) {
        unsigned* bar = b.bar;
        __builtin_amdgcn_s_waitcnt(0);
        unsigned nloc = b.st[0], nx = b.st[1];
        if (nloc == 0u) { xcd_barrier_complete(bar, b.x, nloc, nx); b.st[0] = nloc; b.st[1] = nx; }
        const unsigned old = xb_add(&bar[XB_XSUB(b.x)], 1u);
        const unsigned gen = old / nloc;
        if (old + 1u == (gen + 1u) * nloc) {
            __builtin_amdgcn_fence(__ATOMIC_RELEASE, "agent");
            asm volatile("s_waitcnt vmcnt(0)" ::: "memory");
            const unsigned og = xb_add(&bar[XB_TOP], 1u);
            const unsigned tg = og / nx;
            if (og + 1u == (tg + 1u) * nx) xb_add(&bar[XB_TOPGEN], 1u);
            else XB_SPIN(xb_ld(&bar[XB_TOPGEN]) == tg, bar);
            __builtin_amdgcn_fence(__ATOMIC_ACQUIRE, "agent");
            xb_add(&bar[XB_XGEN(b.x)], 1u);
            asm volatile("s_waitcnt vmcnt(0)" ::: "memory");
        } else {
            XB_SPIN(xb_ld(&bar[XB_XGEN(b.x)]) == gen, bar);
            __builtin_amdgcn_fence(__ATOMIC_ACQUIRE, "agent");
            asm volatile("s_waitcnt vmcnt(0)" ::: "memory");
        }
    }
    __syncthreads();
}


__device__ __forceinline__ f32x2 ln_stats(f32x2 s) {
    const float mean = s.x * (1.f / DM), var = fmaxf(s.y * (1.f / DM) - mean * mean, 0.f), rstd = __builtin_amdgcn_rsqf(var + 1e-5f);
    return (f32x2){rstd, rstd * mean};
}
__device__ __forceinline__ f32x2 ln_row(const float* st, int row) {
    const f32x2 s = *(const f32x2*)(st + (size_t)row * 2);
    const float mean = s.x * (1.f / DM), var = fmaxf(s.y * (1.f / DM) - mean * mean, 0.f), rstd = 1.0f / sqrtf(var + 1e-5f);
    return (f32x2){rstd, rstd * mean};
}
template <bool LNF> struct EpiSwiglu {
    static constexpr bool PERM = true, AFTER_DRAIN = false, PF = LNF;
    bf16* H; const float *st, *cs, *bb;
    __device__ __forceinline__ const float* pf_stats() const { return st; }
    __device__ __forceinline__ const float* pf_vec0() const { return cs; }
    __device__ __forceinline__ const float* pf_vec1() const { return bb; }
    __device__ __forceinline__ void operator()(const f32x4 (&acc)[2][2][4][2], const pg8::Unit& u, int wr, int wc, int fr, int fq, const LAS unsigned char* ops) const {
        const int row0 = u.pm * 256 + wr * 64 + fr, col0 = u.pn * 128 + wc * 32 + 8 * fq;
        f32x4 csv[2][2], bbv[2][2];
        if constexpr (LNF) {
#pragma unroll
            for (int bj = 0; bj < 2; ++bj)
#pragma unroll
                for (int n = 0; n < 2; ++n) { const int nn = bj * 128 + wc * 32 + 8 * fq + 4 * n; csv[bj][n] = *(const LAS f32x4*)(ops + 2048 + nn * 4); bbv[bj][n] = *(const LAS f32x4*)(ops + 3072 + nn * 4); }
        }
        f32x2 rsv[2][4];
        if constexpr (LNF) {
#pragma unroll
            for (int ai = 0; ai < 2; ++ai)
#pragma unroll
                for (int m = 0; m < 4; ++m) rsv[ai][m] = *(const LAS f32x2*)(ops + (wr * 64 + fr + ai * 128 + m * 16) * 8);
        }
#pragma unroll
        for (int ai = 0; ai < 2; ++ai)
#pragma unroll
            for (int m = 0; m < 4; ++m) {
                const int row = row0 + ai * 128 + m * 16;
                f32x4 g0 = acc[ai][0][m][0], g1 = acc[ai][0][m][1], u0 = acc[ai][1][m][0], u1 = acc[ai][1][m][1];
                if constexpr (LNF) { const f32x2 rs = ln_stats(rsv[ai][m]);
                    g0 = g0 * rs.x - csv[0][0] * rs.y + bbv[0][0]; g1 = g1 * rs.x - csv[0][1] * rs.y + bbv[0][1];
                    u0 = u0 * rs.x - csv[1][0] * rs.y + bbv[1][0]; u1 = u1 * rs.x - csv[1][1] * rs.y + bbv[1][1]; }
                const f32x4 h0 = silu4(g0) * u0, h1 = silu4(g1) * u1;
                u32x4 w; w.x = pkbf(h0[0], h0[1]); w.y = pkbf(h0[2], h0[3]); w.z = pkbf(h1[0], h1[1]); w.w = pkbf(h1[2], h1[3]);
                *(u32x4*)(H + (size_t)row * DFF + col0) = w;
            }
    }
};
template <int MODE> struct EpiResid {
    static constexpr bool PERM = false, AFTER_DRAIN = false, RLN = MODE != 0, OUTB = MODE != 2, PF = RLN, OUTF = MODE == 2, P8 = MODE != 2;
    static constexpr int CQ = P8 ? 8 : 4, CN = P8 ? 4 : 16;
    unsigned char* ws; const float* xin; const float *lg, *lb; float scale;
    __device__ __forceinline__ const float* pf_stats() const { return (const float*)(ws + (MODE == 1 ? CW_ST1 : CW_ST2)); }
    __device__ __forceinline__ const float* pf_vec0() const { return lg; }
    __device__ __forceinline__ const float* pf_vec1() const { return lb; }
    __device__ __forceinline__ void operator()(const f32x4 (&acc)[2][2][4][2], const pg8::Unit& u, int wr, int wc, int fr, int fq, const LAS unsigned char* ops) const {
        const int row0 = u.pm * 256 + wr * 64 + fr, col0 = u.pn * 256 + wc * 32 + CQ * fq;
        float* const out = (float*)(ws + WS_PRE); bf16* const outb = (bf16*)(ws + WS_X1B);
        float* const stn = (float*)(ws + (MODE == 0 ? CW_ST1 : CW_ST2));
        const LAS unsigned char* const opv = ops + 2048 + (wc * 32 + CQ * fq) * 4;
        const LAS unsigned char* const opr = ops + (wr * 64 + fr) * 8;
        u32x4 xa[2][2], xb[2][2];
#define ER_LOAD(X, R) { _Pragma("unroll") for (int bj = 0; bj < 2; ++bj) _Pragma("unroll") for (int n = 0; n < 2; ++n) { \
            const size_t i_ = (size_t)(row0 + ((R) >> 2) * 128 + ((R) & 3) * 16) * DM + col0 + bj * 128 + n * CN; \
            if constexpr (RLN && P8) { if (n == 0) { const u32x4 t_ = *(const u32x4*)(outb + i_); X[bj][0].x = t_.x; X[bj][0].y = t_.y; X[bj][1].x = t_.z; X[bj][1].y = t_.w; } } \
            else if constexpr (RLN) { const u32x2 t_ = *(const u32x2*)(outb + i_); X[bj][n].x = t_.x; X[bj][n].y = t_.y; } else X[bj][n] = *(const u32x4*)(xin + i_); } }
#define ER_DO(X, R) { const int ai = (R) >> 2, m = (R) & 3; const int row = row0 + ai * 128 + m * 16; const size_t ro = (size_t)row * DM + col0; \
            f32x2 rs = {0.f, 0.f}; if constexpr (RLN) rs = ln_stats(*(const LAS f32x2*)(opr + (ai * 128 + m * 16) * 8)); \
            float s1 = 0.f, s2 = 0.f; u32x2 pk0_ = {0u, 0u}; \
            _Pragma("unroll") for (int bj = 0; bj < 2; ++bj) _Pragma("unroll") for (int n = 0; n < 2; ++n) { f32x4 x; \
                if constexpr (RLN) x = (unpk4((u32x2){X[bj][n].x, X[bj][n].y}) * rs.x - rs.y) * *(const LAS f32x4*)(opv + (bj * 128 + n * CN) * 4) + *(const LAS f32x4*)(opv + 1024 + (bj * 128 + n * CN) * 4); \
                else x = __builtin_bit_cast(f32x4, X[bj][n]); \
                const f32x4 o = x * DN_ALPHA + acc[ai][bj][m][n] * scale; \
                if constexpr (OUTF) *(f32x4*)(out + ro + bj * 128 + n * CN) = o; \
                if constexpr (OUTB) { const u32x2 pk_ = pk4(o); if (n == 0) { pk0_ = pk_; } else { *(u32x4*)(outb + ro + bj * 128) = (u32x4){pk0_.x, pk0_.y, pk_.x, pk_.y}; } \
                    s1 += (o[0] + o[1]) + (o[2] + o[3]); s2 += (o[0] * o[0] + o[1] * o[1]) + (o[2] * o[2] + o[3] * o[3]); } } \
            if constexpr (OUTB) { s1 += __shfl_xor(s1, 16); s1 += __shfl_xor(s1, 32); s2 += __shfl_xor(s2, 16); s2 += __shfl_xor(s2, 32); \
                if (fq == 0) { atomicAdd(stn + (size_t)row * 2, s1); atomicAdd(stn + (size_t)row * 2 + 1, s2); } } }
        ER_LOAD(xa, 0)
#pragma unroll
        for (int r = 0; r < 8; r += 2) {
            ER_LOAD(xb, r + 1)
            __builtin_amdgcn_sched_barrier(0);
            ER_DO(xa, r)
            __builtin_amdgcn_sched_barrier(0);
            if (r + 2 < 8) ER_LOAD(xa, r + 2)
            __builtin_amdgcn_sched_barrier(0);
            ER_DO(xb, r + 1)
            __builtin_amdgcn_sched_barrier(0);
        }
#undef ER_DO
#undef ER_LOAD
    }
};
struct EpiLn3 {
    static constexpr bool PERM = false, AFTER_DRAIN = false, PF = true;
    unsigned char* ws; const float *lg, *lb, *g3, *b3; float* yout;
    __device__ __forceinline__ const float* pf_stats() const { return (const float*)(ws + CW_ST2); }
    __device__ __forceinline__ const float* pf_vec0() const { return lg; }
    __device__ __forceinline__ const float* pf_vec1() const { return lb; }
    __device__ __forceinline__ void operator()(f32x4 (&acc)[2][2][4][2], const pg8::Unit& u, int wr, int wc, int fr, int fq, const LAS unsigned char* ops) const {
        const int row0 = u.pm * 256 + wr * 64 + fr, col0 = u.pn * 256 + wc * 32 + 4 * fq;
        const bf16* const resb = (const bf16*)(ws + WS_X1B);
        float* const stn = (float*)(ws + CW_ST3);
        {
            const LAS unsigned char* const opv = ops + 2048 + (wc * 32 + 4 * fq) * 4;
            const LAS unsigned char* const opr = ops + (wr * 64 + fr) * 8;
            u32x2 xa[2][2], xb[2][2];
#define L3_LOAD(X, R) { _Pragma("unroll") for (int bj = 0; bj < 2; ++bj) _Pragma("unroll") for (int n = 0; n < 2; ++n) \
                X[bj][n] = *(const u32x2*)(resb + (size_t)(row0 + ((R) >> 2) * 128 + ((R) & 3) * 16) * DM + col0 + bj * 128 + n * 16); }
#define L3_DO(X, R) { const int ai = (R) >> 2, m = (R) & 3; const int row = row0 + ai * 128 + m * 16; \
                const f32x2 rs = ln_stats(*(const LAS f32x2*)(opr + (ai * 128 + m * 16) * 8)); \
                float s1 = 0.f, s2 = 0.f; \
                _Pragma("unroll") for (int bj = 0; bj < 2; ++bj) _Pragma("unroll") for (int n = 0; n < 2; ++n) { \
                    const f32x4 x = (unpk4(X[bj][n]) * rs.x - rs.y) * *(const LAS f32x4*)(opv + (bj * 128 + n * 16) * 4) + *(const LAS f32x4*)(opv + 1024 + (bj * 128 + n * 16) * 4); \
                    const f32x4 o = x * DN_ALPHA + acc[ai][bj][m][n] * 0.5f; \
                    acc[ai][bj][m][n] = o; \
                    s1 += (o[0] + o[1]) + (o[2] + o[3]); s2 += (o[0] * o[0] + o[1] * o[1]) + (o[2] * o[2] + o[3] * o[3]); } \
                s1 += __shfl_xor(s1, 16); s1 += __shfl_xor(s1, 32); s2 += __shfl_xor(s2, 16); s2 += __shfl_xor(s2, 32); \
                if (fq == 0) { atomicAdd(stn + (size_t)row * 2, s1); atomicAdd(stn + (size_t)row * 2 + 1, s2); } }
            L3_LOAD(xa, 0)
#pragma unroll
            for (int r = 0; r < 8; r += 2) {
                L3_LOAD(xb, r + 1)
                __builtin_amdgcn_sched_barrier(0);
                L3_DO(xa, r)
                __builtin_amdgcn_sched_barrier(0);
                if (r + 2 < 8) L3_LOAD(xa, r + 2)
                __builtin_amdgcn_sched_barrier(0);
                L3_DO(xb, r + 1)
                __builtin_amdgcn_sched_barrier(0);
            }
#undef L3_DO
#undef L3_LOAD
        }
        asm volatile("s_waitcnt vmcnt(0)" ::: "memory");
        __syncthreads();
        if (threadIdx.x == 0) {
            unsigned* bar = (unsigned*)(ws + WS_CTL); unsigned* pc = (unsigned*)(ws + CW_PCNT) + u.pm * 16;
            (void)xb_add(pc, 1u);
            XB_SPIN(xb_ld(pc) < 8u, bar);
        }
        __syncthreads();
        f32x4 gv[2][2], bv[2][2];
#pragma unroll
        for (int bj = 0; bj < 2; ++bj)
#pragma unroll
            for (int n = 0; n < 2; ++n) { gv[bj][n] = *(const f32x4*)(g3 + col0 + bj * 128 + n * 16); bv[bj][n] = *(const f32x4*)(b3 + col0 + bj * 128 + n * 16); }
#pragma unroll
        for (int ai = 0; ai < 2; ++ai) {
            f32x2 rsv[4];
#pragma unroll
            for (int m = 0; m < 4; ++m) { const float* sp = stn + (size_t)(row0 + ai * 128 + m * 16) * 2;
                rsv[m] = (f32x2){__hip_atomic_load(sp, __ATOMIC_RELAXED, __HIP_MEMORY_SCOPE_AGENT), __hip_atomic_load(sp + 1, __ATOMIC_RELAXED, __HIP_MEMORY_SCOPE_AGENT)}; }
#pragma unroll
            for (int m = 0; m < 4; ++m) {
                const f32x2 rs = ln_stats(rsv[m]);
                float* const yo = yout + (size_t)(row0 + ai * 128 + m * 16) * DM + col0;
#pragma unroll
                for (int bj = 0; bj < 2; ++bj)
#pragma unroll
                    for (int n = 0; n < 2; ++n) __builtin_nontemporal_store((acc[ai][bj][m][n] * rs.x - rs.y) * gv[bj][n] + bv[bj][n], (f32x4*)(yo + bj * 128 + n * 16));
            }
        }
    }
};
struct EpiWin {
    static constexpr bool PERM = false, AFTER_DRAIN = false, PF = true;
    unsigned char* ws; unsigned char* outb;
    __device__ __forceinline__ const float* pf_stats() const { return (const float*)(ws + CW_ST1); }
    __device__ __forceinline__ const float* pf_vec0() const { return (const float*)(ws + CW_CSIN); }
    __device__ __forceinline__ const float* pf_vec1() const { return (const float*)(ws + CW_BBIN); }
    __device__ __forceinline__ void operator()(const f32x4 (&accr)[2][2][4][2], const pg8::Unit& u, int wr, int wc, int fr, int fq, const LAS unsigned char* ops) const {
        const int pn = u.pn;
        f32x4 csv[2][2], bbv[2][2];
#pragma unroll
        for (int bj = 0; bj < 2; ++bj)
#pragma unroll
            for (int n = 0; n < 2; ++n) { const unsigned nn = bj * 128u + 32u * wc + 16u * n + 4u * fq;
                csv[bj][n] = *(const LAS f32x4*)(ops + 2048u + nn * 4u); bbv[bj][n] = *(const LAS f32x4*)(ops + 3072u + nn * 4u); }
#define WST8(off, v) (*(u32x2*)(ws + (unsigned)(off)) = (v))
#define WSTB16(off, a_, b_) do { const u32x2 a__ = pk4(a_), b__ = pk4(b_); *(u32x4*)(ws + (unsigned)(off)) = (u32x4){a__.x, a__.y, b__.x, b__.y}; } while (0)
#define WST16(off, v) (*(f32x4*)(ws + (unsigned)(off)) = (v))
#define OST16(off, v) (*(f32x4*)(outb + (unsigned)(off)) = (v))
#pragma unroll
        for (int ai = 0; ai < 2; ++ai) {
            f32x2 rsv[4];
#pragma unroll
            for (int m = 0; m < 4; ++m) rsv[m] = *(const LAS f32x2*)(ops + (unsigned)(ai * 128 + wr * 64 + m * 16 + fr) * 8u);
#pragma unroll
            for (int m = 0; m < 4; ++m) {
                int row = u.pm * 256 + ai * 128 + wr * 64 + m * 16 + fr;
                asm volatile("" : "+v"(row));
                const bool rok = row < MROWS;
                const unsigned pidx = row < MP ? (unsigned)(row & 2047) : 2048u;
                f32x4 acc[2][2]; { const f32x2 rs_ = ln_stats(rsv[m]); const float rstd = rs_.x, rm = rs_.y;
#pragma unroll
                    for (int bj = 0; bj < 2; ++bj)
#pragma unroll
                        for (int n = 0; n < 2; ++n) acc[bj][n] = accr[ai][bj][m][n] * rstd - csv[bj][n] * rm + bbv[bj][n]; }
                if (pn < 12) {
#pragma unroll
                    for (int bj = 0; bj < 2; ++bj) {
                        f32x4 v0 = acc[bj][0], v1 = acc[bj][1];
                        if (pn < 10 && wc == 0) {
                            const unsigned ro = (unsigned)WS_ROPEA + (pidx * 16u + 4u * fq) * 8u;
                            const f32x4 ra = *(const f32x4*)(ws + ro), rb = *(const f32x4*)(ws + ro + 16u);
                            const float c[4] = {ra[0], ra[2], rb[0], rb[2]}, s[4] = {ra[1], ra[3], rb[1], rb[3]};
#pragma unroll
                            for (int j = 0; j < 4; ++j) { const float x1 = v0[j], x2 = v1[j]; v0[j] = x1 * c[j] - x2 * s[j]; v1[j] = x2 * c[j] + x1 * s[j]; }
                        }
                        if (rok) {
                            const bool nat = pn < 10 && wc == 0;
                            const unsigned d0 = nat ? 4u * fq : 32u * wc + 8u * fq, d1 = nat ? 16u : 4u;
                            if (pn < 8) { const unsigned o = (unsigned)WS_Q + ((unsigned)row * DM + (2u * pn + bj) * 128u + d0) * 2u;
                                if (nat) { WST8(o, pk4(v0 * QSCALE)); WST8(o + 32u, pk4(v1 * QSCALE)); } else WSTB16(o, v0 * QSCALE, v1 * QSCALE); }
                            else { const unsigned kvh = 2u * ((pn - 8) & 1) + bj; const bool isk = pn < 10;
                                const unsigned fo = (row < MP ? (unsigned)(isk ? O_KP : O_VP) + (unsigned)row * 512u : (unsigned)(isk ? O_KS : O_VS) + (unsigned)(row - MP) * 512u) + kvh * 128u + d0;
                                OST16(fo * 4u, v0); OST16((fo + d1) * 4u, v1);
                                const unsigned bo = (unsigned)(isk ? WS_KB : WS_VB) + ((unsigned)row * 512u + kvh * 128u + d0) * 2u;
                                if (nat) { WST8(bo, pk4(v0)); WST8(bo + 32u, pk4(v1)); } else WSTB16(bo, v0, v1); }
                        }
                    }
                } else if (pn < 16) {
#pragma unroll
                    for (int bj = 0; bj < 2; ++bj) {
                        f32x4 v0 = acc[bj][0]; const f32x4 v1 = acc[bj][1];
                        if ((wc & 1) == 0) {
                            const unsigned ro = (unsigned)WS_ROPEI + (pidx * 8u + 4u * (fq & 1)) * 8u;
                            const f32x4 ra = *(const f32x4*)(ws + ro), rb = *(const f32x4*)(ws + ro + 16u);
                            const float c[4] = {ra[0], ra[2], rb[0], rb[2]}, s[4] = {ra[1], ra[3], rb[1], rb[3]};
#pragma unroll
                            for (int j = 0; j < 4; ++j) { const float own = v0[j], oth = __shfl_xor(own, 32); v0[j] = (fq < 2) ? own * c[j] - oth * s[j] : own * c[j] + oth * s[j]; }
                        }
                        if (rok) {
                            const bool nat = (wc & 1) == 0;
                            const unsigned ih = 4u * (pn - 12) + 2u * bj + (wc >> 1), d0 = nat ? 4u * fq : 32u + 8u * fq, d1 = nat ? 16u : 4u;
                            const unsigned o = (unsigned)WS_QI + ((unsigned)row * 1024u + ih * 64u + d0) * 2u;
                            if (nat) { WST8(o, pk4(v0)); WST8(o + 32u, pk4(v1)); } else WSTB16(o, v0, v1);
                            if (row >= MP) { const unsigned fo = (unsigned)WS_QIS + ((unsigned)(row - MP) * 1024u + ih * 64u + d0) * 4u; WST16(fo, v0); WST16(fo + d1 * 4u, v1); }
                        }
                    }
                } else if (pn < 40) {
                    if (rok) {
#pragma unroll
                        for (int bj = 0; bj < 2; ++bj) { const unsigned col = (unsigned)(pn - 16) * 256u + bj * 128u + 32u * wc + 8u * fq;
                            WSTB16((unsigned)WS_RAW + ((unsigned)row * CONVD + col) * 2u, acc[bj][0], acc[bj][1]);
                            if (row >= MP) { const unsigned fo = ((unsigned)O_CONVS + ((unsigned)(row - MP) * 3u + 2u) * CONVD + col) * 4u; OST16(fo, acc[bj][0]); OST16(fo + 16u, acc[bj][1]); }
                            else if ((row & 2047) >= 2045) { const unsigned fo = ((unsigned)O_CONVP + ((unsigned)(row >> 11) * 3u + (unsigned)((row & 2047) - 2045)) * CONVD + col) * 4u; OST16(fo, acc[bj][0]); OST16(fo + 16u, acc[bj][1]); } }
                    }
                } else if (pn < 64) {
                    if (rok) {
                        const unsigned dbase = (unsigned)((pn < 48) ? WS_ZS : (pn < 56) ? WS_GA : WS_GB);
#pragma unroll
                        for (int bj = 0; bj < 2; ++bj) { const unsigned col = (unsigned)((pn - 40) & 7) * 256u + bj * 128u + 32u * wc + 8u * fq;
                            if (pn < 48) WSTB16(dbase + ((unsigned)row * DM + col) * 2u, silu4(acc[bj][0]), silu4(acc[bj][1]));
                            else WSTB16(dbase + ((unsigned)row * DM + col) * 2u, acc[bj][0], acc[bj][1]); }
                    }
                } else {
                    f32x4 v0 = acc[0][0]; const f32x4 v1 = acc[0][1];
                    if (wc == 0) {
                        const unsigned ro = (unsigned)WS_ROPEI + (pidx * 8u + 4u * (fq & 1)) * 8u;
                        const f32x4 ra = *(const f32x4*)(ws + ro), rb = *(const f32x4*)(ws + ro + 16u);
                        const float c[4] = {ra[0], ra[2], rb[0], rb[2]}, s[4] = {ra[1], ra[3], rb[1], rb[3]};
#pragma unroll
                        for (int j = 0; j < 4; ++j) { const float own = v0[j], oth = __shfl_xor(own, 32); v0[j] = (fq < 2) ? own * c[j] - oth * s[j] : own * c[j] + oth * s[j]; }
                    }
                    if (rok) {
                        if (wc < 2) { const unsigned d0 = 32u * wc + 4u * fq;
                            const unsigned fo = (row < MP ? (unsigned)O_IKP + (unsigned)row * 64u : (unsigned)O_IKS + (unsigned)(row - MP) * 64u) + d0; OST16(fo * 4u, v0); OST16(fo * 4u + 64u, v1);
                            const unsigned bo = (unsigned)WS_KI + ((unsigned)row * 64u + d0) * 2u; WST8(bo, pk4(v0)); WST8(bo + 32u, pk4(v1)); }
                        else if (wc == 2) {
                            WST16((unsigned)WS_WIDX + ((unsigned)row * 16u + 4u * fq) * 4u, v0 * 0.03125f);
                            f32x4 g;
                            unsigned go = (unsigned)CW_GDNA + 16u * fq; asm volatile("" : "+v"(go));
                            const f32x4 na = *(const f32x4*)(ws + go), db = *(const f32x4*)(ws + go + 64u);
#pragma unroll
                            for (int j = 0; j < 4; ++j) { const float xx = v1[j] + db[j]; const float sp = fmaxf(xx, 0.f) + __logf(1.f + __expf(-fabsf(xx))); g[j] = na[j] * sp; }
                            WST16((unsigned)WS_GDEC + ((unsigned)row * 16u + 4u * fq) * 4u, g); }
                        else { WST16((unsigned)WS_BETA + ((unsigned)row * 16u + 4u * fq) * 4u, sigm4(v0)); }
                    }
                }
            }
        }
#undef WST8
#undef WSTB16
#undef WST16
#undef OST16
    }
};

__device__ __forceinline__ float wave_sum(float v) {
#pragma unroll
    for (int o = 1; o < 64; o <<= 1) v += __shfl_xor(v, o);
    return v;
}
__device__ __forceinline__ void ln_phase(const float* src, const float* g, const float* b, float* dst_p, float* dst_s, bf16* dstb, int row_begin) {
    const int tid = otid(), lane = tid & 63, wid = tid >> 6;
    const int gw = blockIdx.x * 8 + wid, NGW = gridDim.x * 8;
    for (int row0 = row_begin + gw; row0 < MROWS; row0 += 2 * NGW) {
        const int row1 = row0 + NGW; const bool two = row1 < MROWS;
        f32x4 v[2][8];
#pragma unroll
        for (int j = 0; j < 8; ++j) v[0][j] = *(const f32x4*)(src + (size_t)row0 * DM + j * 256 + lane * 4);
#pragma unroll
        for (int j = 0; j < 8; ++j) v[1][j] = *(const f32x4*)(src + (size_t)(two ? row1 : row0) * DM + j * 256 + lane * 4);
#pragma unroll
        for (int q = 0; q < 2; ++q) {
            if (q == 1 && !two) break;
            const int row = q ? row1 : row0;
            float s = 0.f;
#pragma unroll
            for (int j = 0; j < 8; ++j) s += (v[q][j][0] + v[q][j][1]) + (v[q][j][2] + v[q][j][3]);
            const float mean = wave_sum(s) * (1.f / DM); float s2 = 0.f;
#pragma unroll
            for (int j = 0; j < 8; ++j) { v[q][j] = v[q][j] - mean; s2 += (v[q][j][0] * v[q][j][0] + v[q][j][1] * v[q][j][1]) + (v[q][j][2] * v[q][j][2] + v[q][j][3] * v[q][j][3]); }
            const float rstd = 1.0f / sqrtf(wave_sum(s2) * (1.f / DM) + 1e-5f);
            float* of = row < MP ? dst_p + (size_t)row * DM : dst_s + (size_t)(row - MP) * DM;
#pragma unroll
            for (int j = 0; j < 8; ++j) { const f32x4 gg = *(const f32x4*)(g + j * 256 + lane * 4), bb = *(const f32x4*)(b + j * 256 + lane * 4);
                const f32x4 o = v[q][j] * rstd * gg + bb; *(f32x4*)(of + j * 256 + lane * 4) = o;
                if (dstb) *(u32x2*)(dstb + (size_t)row * DM + j * 256 + lane * 4) = pk4(o); }
        }
    }
}

template <int MODE>
__device__ __forceinline__ void skinny_phase(const bf16* A, const bf16* Bt, int N, int K, unsigned char* ws, const float* xin, const float* lg, const float* lb, float scale, LAS unsigned char* lds) {
    constexpr bool RLN = MODE != 0, OUTB = MODE != 2;
    float* const out = (float*)(ws + WS_PRE) + (size_t)MP * DM; bf16* const outb = (bf16*)(ws + WS_X1B) + (size_t)MP * DM;
    const float* const res = RLN ? (const float*)(ws + WS_PRE) + (size_t)MP * DM : xin;
    const float* const sto = (const float*)(ws + (MODE == 1 ? CW_ST1 : CW_ST2)) + (size_t)MP * 2; float* const stn = (float*)(ws + (MODE == 0 ? CW_ST1 : CW_ST2)) + (size_t)MP * 2;
    const float alpha = DN_ALPHA;
    const int tid = otid(), lane = tid & 63, wid = tid >> 6, fr = lane & 15, fq = lane >> 4;
    LAS f32x4* red = (LAS f32x4*)lds;
    const int kper = K / 8, k0 = wid * kper, nsteps = kper / 32;
    for (int item = blockIdx.x; item < N / 16; item += gridDim.x) {
        const int n0 = item * 16;
        const bf16* wp = Bt + (size_t)(n0 + fr) * K + k0 + 8 * fq;
        const bf16* ap = A + (size_t)(fr & 7) * K + k0 + 8 * fq;
        f32x4 acc = {0.f, 0.f, 0.f, 0.f};
#pragma unroll 4
        for (int s = 0; s < nsteps; ++s) {
            const bf16x8 wf = *(const bf16x8*)(wp + s * 32);
            bf16x8 af = *(const bf16x8*)(ap + s * 32);
            if (fr >= 8) af = (bf16x8){0, 0, 0, 0, 0, 0, 0, 0};
            acc = __builtin_amdgcn_mfma_f32_16x16x32_bf16(wf, af, acc, 0, 0, 0);
        }
        __syncthreads();
        red[wid * 64 + lane] = acc;
        __syncthreads();
        if (wid == 0) {
            f32x4 t = red[lane];
#pragma unroll
            for (int w = 1; w < 8; ++w) t += red[w * 64 + lane];
            const int d = fr & 7;
            const int cl = (MODE == 2) ? n0 + 4 * fq : (n0 & ~31) + 8 * fq + 4 * ((n0 >> 4) & 1);
            const size_t o = (size_t)d * DM + cl;
            f32x4 xr = *(const f32x4*)(res + o);
            if constexpr (RLN) { const f32x2 rs = ln_row(sto, d); xr = (xr * rs.x - rs.y) * *(const f32x4*)(lg + cl) + *(const f32x4*)(lb + cl); }
            const f32x4 v = xr * alpha + t * scale;
            if (fr < 8) *(f32x4*)(out + o) = v;
            if constexpr (OUTB) {
                if (fr < 8) *(u32x2*)(outb + o) = pk4(v);
                float s1 = (v[0] + v[1]) + (v[2] + v[3]), s2 = (v[0] * v[0] + v[1] * v[1]) + (v[2] * v[2] + v[3] * v[3]);
                s1 += __shfl_xor(s1, 16); s1 += __shfl_xor(s1, 32); s2 += __shfl_xor(s2, 16); s2 += __shfl_xor(s2, 32);
                if (lane < 8) { atomicAdd(stn + (size_t)d * 2, s1); atomicAdd(stn + (size_t)d * 2 + 1, s2); }
            }
        }
    }
}

__device__ __forceinline__ void conv_row(const P& p, int row) {
    const int tid = otid();
    const bf16* RAW = (const bf16*)(p.ws + WS_RAW);
    bf16* QH = (bf16*)(p.ws + WS_QH); bf16* KH = (bf16*)(p.ws + WS_KH); bf16* VH = (bf16*)(p.ws + WS_VH);
    {
        const int t = row & 2047;
#pragma unroll
        for (int part = 0; part < 3; ++part) {
            const int ch = part * 2048 + tid * 4;
            f32x4 y = {0.f, 0.f, 0.f, 0.f};
#pragma unroll
            for (int j = 0; j < 4; ++j) {
                const f32x4 w = *(const f32x4*)(p.convw + (size_t)j * CONVD + ch);
                f32x4 x;
                if (row < MP) { if (t - 3 + j < 0) x = (f32x4){0.f, 0.f, 0.f, 0.f}; else x = unpk4(*(const u32x2*)(RAW + (size_t)(row - 3 + j) * CONVD + ch)); }
                else { const int d = row - MP; x = (j < 3) ? *(const f32x4*)(p.state_conv + ((size_t)d * 3 + j) * CONVD + ch) : *(const f32x4*)(p.out + O_CONVS + ((size_t)d * 3 + 2) * CONVD + ch); }
                y += w * x;
            }
            f32x4 s = silu4(y);
            if (part < 2) {
                float ss = (s[0] * s[0] + s[1] * s[1]) + (s[2] * s[2] + s[3] * s[3]);
#pragma unroll
                for (int o = 1; o < 32; o <<= 1) ss += __shfl_xor(ss, o);
                const float sc = (1.0f / sqrtf(ss + 1e-6f)) * (part == 0 ? 0.08838834764831845f : 1.f);
                s = s * sc;
            }
            bf16* dst = (part == 0 ? QH : part == 1 ? KH : VH) + (size_t)row * DM + tid * 4;
            *(u32x2*)dst = pk4(s);
        }
    }
}

__device__ __forceinline__ void gdn_naive_phase(const P& p, LAS unsigned char* lds, int first_wg, int ngrp) {
    const int tid = otid(), dv = tid & 127, kg = tid >> 7;
    const bf16* QH = (const bf16*)(p.ws + WS_QH); const bf16* KH = (const bf16*)(p.ws + WS_KH); const bf16* VH = (const bf16*)(p.ws + WS_VH);
    const float* GDEC = (const float*)(p.ws + WS_GDEC); const float* BETA = (const float*)(p.ws + WS_BETA); bf16* OB = (bf16*)(p.ws + WS_OB);
    LAS float* kq = (LAS float*)lds;
    LAS float* red = kq + 256;
    LAS float* red2 = red + 512;
    for (int item = ((int)blockIdx.x >= first_wg && (int)blockIdx.x < first_wg + ngrp) ? 64 + (int)blockIdx.x - first_wg : 192; item < 192; item += ngrp) {
        const int seq = item >> 4, h = item & 15;
        const int T = seq < 4 ? SEQ : 1, row0 = seq < 4 ? seq * SEQ : MP + (seq - 4);
        float S[32];
        if (seq < 4) {
#pragma unroll
            for (int i = 0; i < 32; ++i) S[i] = 0.f;
        } else {
#pragma unroll
            for (int i = 0; i < 32; ++i) S[i] = p.state_ssm[(((size_t)(seq - 4) * 16 + h) * 128 + 32 * kg + i) * 128 + dv];
        }
        for (int t = 0; t < T; ++t) {
            const int row = row0 + t;
            __syncthreads();
            if (tid < 256) kq[tid] = bf2f((tid < 128 ? KH : QH)[(size_t)row * DM + h * 128 + (tid & 127)]);
            const float gd = __expf(GDEC[row * 16 + h]), beta = BETA[row * 16 + h];
            const float v = bf2f(VH[(size_t)row * DM + h * 128 + dv]);
            __syncthreads();
            float part = 0.f;
#pragma unroll
            for (int i = 0; i < 32; ++i) { S[i] *= gd; part += kq[32 * kg + i] * S[i]; }
            red[kg * 128 + dv] = part;
            __syncthreads();
            const float kS = (red[dv] + red[128 + dv]) + (red[256 + dv] + red[384 + dv]);
            const float vn = beta * (v - kS);
            float op = 0.f;
#pragma unroll
            for (int i = 0; i < 32; ++i) { S[i] += kq[32 * kg + i] * vn; op += kq[128 + 32 * kg + i] * S[i]; }
            red2[kg * 128 + dv] = op;
            __syncthreads();
            if (kg == 0) OB[(size_t)row * DM + h * 128 + dv] = (bf16)(pkbf((red2[dv] + red2[128 + dv]) + (red2[256 + dv] + red2[384 + dv]), 0.f) & 0xffffu);
        }
        float* so = seq < 4 ? p.out + O_SSMP + ((size_t)seq * 16 + h) * 16384 : p.out + O_SSMS + ((size_t)(seq - 4) * 16 + h) * 16384;
#pragma unroll
        for (int i = 0; i < 32; ++i) so[(size_t)(32 * kg + i) * 128 + dv] = S[i];
    }
}

__device__ __forceinline__ void merge_phase(const P& p) {
    const int tid = otid(), lane = tid & 63, wid = tid >> 6;
    const int gw = blockIdx.x * 8 + wid, NGW = gridDim.x * 8;
    const bf16* OA = (const bf16*)(p.ws + WS_OA); const bf16* OB = (const bf16*)(p.ws + WS_OB);
    const bf16* ZS = (const bf16*)(p.ws + WS_ZS); const bf16* GA = (const bf16*)(p.ws + WS_GA); const bf16* GB = (const bf16*)(p.ws + WS_GB);
    bf16* MRG = (bf16*)(p.ws + WS_MRG);
    const f32x4 gn = *(const f32x4*)(p.gng + (lane & 31) * 4);
    for (int row = gw; row < MROWS; row += NGW) {
#pragma unroll
        for (int pass = 0; pass < 8; ++pass) {
            const size_t o = (size_t)row * DM + (2 * pass + (lane >> 5)) * 128 + (lane & 31) * 4;
            const f32x4 ob = unpk4(*(const u32x2*)(OB + o));
            float ss = (ob[0] * ob[0] + ob[1] * ob[1]) + (ob[2] * ob[2] + ob[3] * ob[3]);
#pragma unroll
            for (int s = 1; s < 32; s <<= 1) ss += __shfl_xor(ss, s);
            const float r = 1.0f / sqrtf(ss * (1.f / 128.f) + 1e-6f);
            const f32x4 zs = unpk4(*(const u32x2*)(ZS + o)), ga = sigm4(unpk4(*(const u32x2*)(GA + o))), gb = sigm4(unpk4(*(const u32x2*)(GB + o))), oa = unpk4(*(const u32x2*)(OA + o));
            const f32x4 mr = ga * oa + gb * (ob * r * gn * zs);
            *(u32x2*)(MRG + o) = pk4(mr);
        }
    }
}

#define MFMA32(a, b, c) __builtin_amdgcn_mfma_f32_32x32x16_bf16(a, b, c, 0, 0, 0)

__device__ __forceinline__ unsigned ord_u32(float v) { const unsigned b = __builtin_bit_cast(unsigned, v); return (b & 0x80000000u) ? ~b : (b | 0x80000000u); }

__device__ __forceinline__ void idx_select_row(const float* SC, unsigned* MASK, int row, int lane) {
    const int t = row & 2047;
    unsigned* mrow = MASK + (size_t)row * 64;
    if (t < 256) {
        if (lane < 32) { u32x2 w;
#pragma unroll
            for (int e = 0; e < 2; ++e) { const int lo = 32 * (2 * lane + e); w[e] = (lo + 31 <= t) ? 0xffffffffu : (lo > t) ? 0u : ((1u << (t - lo + 1)) - 1u); }
            *(u32x2*)(mrow + 2 * lane) = w; }
        return;
    }
    const float* srow = SC + (size_t)row * SEQ;
    unsigned u[32];
    {   float sv[32];
#pragma unroll
        for (int i = 0; i < 32; ++i) sv[i] = (i * 64 <= t) ? srow[i * 64 + lane] : 0.f;
#pragma unroll
        for (int i = 0; i < 32; ++i) u[i] = (i * 64 + lane <= t) ? ord_u32(sv[i]) : 0u;
    }
    unsigned tau = 0u;
    for (int bit = 31; bit >= 0; --bit) {
        const unsigned cand = tau | (1u << bit); int cnt = 0;
#pragma unroll
        for (int g = 0; g < 4; ++g) {
            unsigned long long mk[8];
#pragma unroll
            for (int j = 0; j < 8; ++j) mk[j] = __ballot(u[8 * g + j] >= cand);
            __builtin_amdgcn_sched_barrier(0);
#pragma unroll
            for (int j = 0; j < 8; ++j) cnt += __popcll(mk[j]);
            __builtin_amdgcn_sched_barrier(0);
        }
        if (cnt >= 256) tau = cand;
        if (cnt == 256) break;
    }
    unsigned long long mine = 0ull;
#pragma unroll
    for (int i = 0; i < 32; ++i) { const unsigned long long bal = __ballot(u[i] >= tau); if (lane == i) mine = bal; }
    if (lane < 32) *(unsigned long long*)(mrow + 2 * lane) = mine;
}

__device__ __forceinline__ void idx_item(const P& p, LAS unsigned char* lds, int item) {
    const int tid = otid(), lane = tid & 63, wid = tid >> 6, r32 = lane & 31, hi = lane >> 5;
    const bf16* QI = (const bf16*)(p.ws + WS_QI); const bf16* KI = (const bf16*)(p.ws + WS_KI); const float* WIDX = (const float*)(p.ws + WS_WIDX);
    float* SC = (float*)(p.ws + WS_SC); unsigned* MASK = (unsigned*)(p.ws + WS_MASK);
    {
        const int b = item & 3, qb = item < 224 ? 63 - (item >> 2) : (item - 224) >> 2;
        const int rowbase = b * SEQ, t0 = qb * 32;
        if (qb >= 8) {
            lds_barrier();
            {
                u32x4 qv[8]; f32x4 wq = {0.f, 0.f, 0.f, 0.f};
#pragma unroll
                for (int i = 0; i < 8; ++i) { const int c = tid + 512 * i; qv[i] = *(const u32x4*)(QI + (size_t)(rowbase + t0 + (c >> 7)) * 1024 + (c & 127) * 8); }
                if (tid < 128) wq = *(const f32x4*)(WIDX + (size_t)(rowbase + t0) * 16 + tid * 4);
#pragma unroll
                for (int i = 0; i < 8; ++i) { const int c = tid + 512 * i; *(LAS u32x4*)(lds + (c >> 7) * 2064 + (c & 127) * 16) = qv[i]; }
                if (tid < 128) *(LAS f32x4*)(lds + 32 * 2064 + tid * 16) = wq;
            }
            lds_barrier();
            const int npair = (qb + 2) >> 1;
            for (int kp = wid; kp < npair; kp += 8) {
                bf16x8 a[2][4];
#pragma unroll
                for (int e = 0; e < 2; ++e)
#pragma unroll
                    for (int kk = 0; kk < 4; ++kk) a[e][kk] = *(const bf16x8*)(KI + (size_t)(rowbase + min(2 * kp + e, qb) * 32 + r32) * 64 + kk * 16 + hi * 8);
                f32x16 sc[2];
#pragma unroll
                for (int q = 0; q < 16; ++q) { sc[0][q] = 0.f; sc[1][q] = 0.f; }
#pragma unroll 1
                for (int hg = 0; hg < 8; ++hg) {
                    bf16x8 bq[2][4];
#pragma unroll
                    for (int h2 = 0; h2 < 2; ++h2)
#pragma unroll
                        for (int kk = 0; kk < 4; ++kk) bq[h2][kk] = *(const LAS bf16x8*)(lds + r32 * 2064 + (2 * hg + h2) * 128 + kk * 32 + hi * 16);
                    const f32x2 wv = *(const LAS f32x2*)(lds + 32 * 2064 + (r32 * 16 + 2 * hg) * 4);
#pragma unroll
                    for (int e = 0; e < 2; ++e) {
                        f32x16 d0, d1;
#pragma unroll
                        for (int q = 0; q < 16; ++q) { d0[q] = 0.f; d1[q] = 0.f; }
#pragma unroll
                        for (int kk = 0; kk < 4; ++kk) { d0 = MFMA32(a[e][kk], bq[0][kk], d0); d1 = MFMA32(a[e][kk], bq[1][kk], d1); }
#pragma unroll
                        for (int q = 0; q < 16; ++q) sc[e][q] += wv.x * relu_fast(d0[q]) + wv.y * relu_fast(d1[q]);
                    }
                }
#pragma unroll
                for (int e = 0; e < 2; ++e) {
                    const int kb = 2 * kp + e;
                    if (kb <= qb) { float* dst = SC + (size_t)(rowbase + t0 + r32) * SEQ + kb * 32 + 4 * hi;
#pragma unroll
                        for (int g = 0; g < 4; ++g) *(f32x4*)(dst + 8 * g) = (f32x4){sc[e][4 * g], sc[e][4 * g + 1], sc[e][4 * g + 2], sc[e][4 * g + 3]}; }
                }
            }
            __builtin_amdgcn_fence(__ATOMIC_RELEASE, "workgroup");
            __syncthreads();
            __builtin_amdgcn_fence(__ATOMIC_ACQUIRE, "workgroup");
        }
#pragma unroll 1
        for (int rr = 0; rr < 4; ++rr) idx_select_row(SC, MASK, rowbase + t0 + wid * 4 + rr, lane);
    }
}

__device__ __forceinline__ bf16x8 cat8(s16x4 lo, s16x4 hi) { return (bf16x8){lo[0], lo[1], lo[2], lo[3], hi[0], hi[1], hi[2], hi[3]}; }
constexpr int AT_KP = 272, AT_VP = 320, AT_KB = 64 * AT_KP, AT_VB = 64 * AT_VP;
template <int OFF> __device__ __forceinline__ s16x4 tr_read(unsigned addr) { s16x4 r; asm volatile("ds_read_b64_tr_b16 %0, %1 offset:%2" : "=&v"(r) : "v"(addr), "i"(OFF) : "memory"); return r; }

__device__ __forceinline__ void attn_unit(const P& p, LAS unsigned char* lds, int b, int kvh, int qb) {
    const int tid = otid(), lane = tid & 63, wid = tid >> 6, r32 = lane & 31, hi = lane >> 5;
    const bf16* Q = (const bf16*)(p.ws + WS_Q); const bf16* KBp = (const bf16*)(p.ws + WS_KB); const bf16* VBp = (const bf16*)(p.ws + WS_VB);
    const unsigned* MASK = (const unsigned*)(p.ws + WS_MASK); bf16* OA = (bf16*)(p.ws + WS_OA);
    const int g = wid >> 1, head = 4 * kvh + g, q0 = 64 * qb + 32 * (wid & 1);
    const size_t rowq = (size_t)b * SEQ + q0 + r32;
    bf16x8 qf[8];
#pragma unroll
    for (int kk = 0; kk < 8; ++kk) qf[kk] = *(const bf16x8*)(Q + rowq * DM + head * 128 + kk * 16 + hi * 8);
    f32x16 o[4];
#pragma unroll
    for (int mt = 0; mt < 4; ++mt)
#pragma unroll
        for (int r = 0; r < 16; ++r) o[mt][r] = 0.f;
    float mrun = -1e30f, lrun = 0.f;
    const int ntiles = qb + 1;
    const int srow = tid >> 3, sch = tid & 7;
    const bf16* kg = KBp + ((size_t)b * SEQ + srow) * 512 + kvh * 128 + sch * 16;
    const bf16* vg = VBp + ((size_t)b * SEQ + srow) * 512 + kvh * 128 + sch * 16;
    LAS unsigned char* Kl = lds; LAS unsigned char* Vl = lds + 2 * AT_KB;
    u32x4 sk0, sk1, sv0, sv1;
    sk0 = *(const u32x4*)kg; sk1 = *(const u32x4*)(kg + 8); sv0 = *(const u32x4*)vg; sv1 = *(const u32x4*)(vg + 8);
    lds_barrier();
    *(LAS u32x4*)(Kl + srow * AT_KP + sch * 32) = sk0; *(LAS u32x4*)(Kl + srow * AT_KP + sch * 32 + 16) = sk1;
    *(LAS u32x4*)(Vl + srow * AT_VP + sch * 32) = sv0; *(LAS u32x4*)(Vl + srow * AT_VP + sch * 32 + 16) = sv1;
    lds_barrier();
    u32x2 mwn = *(const u32x2*)(MASK + rowq * 64);
    const unsigned vlane = (unsigned)((4 * hi + ((lane >> 2) & 3)) * AT_VP + (16 * ((lane >> 4) & 1) + 4 * (lane & 3)) * 2);
    for (int tile = 0; tile < ntiles; ++tile) {
        const int buf = tile & 1;
        const u32x2 mw = mwn;
        if (tile + 1 < ntiles) { const size_t go = (size_t)(tile + 1) * 64 * 512; mwn = *(const u32x2*)(MASK + rowq * 64 + 2 * (tile + 1));
            sk0 = *(const u32x4*)(kg + go); sk1 = *(const u32x4*)(kg + go + 8); sv0 = *(const u32x4*)(vg + go); sv1 = *(const u32x4*)(vg + go + 8); }
        const LAS unsigned char* Kb = Kl + buf * AT_KB;
        f32x16 p0, p1;
#pragma unroll
        for (int r = 0; r < 16; ++r) { p0[r] = 0.f; p1[r] = 0.f; }
        {
            bf16x8 ka[4], kb2[4], kc[4], kd[4];
#pragma unroll
            for (int kk = 0; kk < 4; ++kk) { ka[kk] = *(const LAS bf16x8*)(Kb + r32 * AT_KP + kk * 32 + hi * 16); kb2[kk] = *(const LAS bf16x8*)(Kb + (32 + r32) * AT_KP + kk * 32 + hi * 16); }
            __builtin_amdgcn_sched_barrier(0);
#pragma unroll
            for (int kk = 0; kk < 4; ++kk) { kc[kk] = *(const LAS bf16x8*)(Kb + r32 * AT_KP + (kk + 4) * 32 + hi * 16); kd[kk] = *(const LAS bf16x8*)(Kb + (32 + r32) * AT_KP + (kk + 4) * 32 + hi * 16); }
#pragma unroll
            for (int kk = 0; kk < 4; ++kk) { p0 = MFMA32(ka[kk], qf[kk], p0); p1 = MFMA32(kb2[kk], qf[kk], p1); }
            __builtin_amdgcn_sched_barrier(0);
#pragma unroll
            for (int kk = 0; kk < 4; ++kk) { p0 = MFMA32(kc[kk], qf[kk + 4], p0); p1 = MFMA32(kd[kk], qf[kk + 4], p1); }
        }
        const unsigned w0 = mw.x >> (4 * hi), w1 = mw.y >> (4 * hi);
        float mt_ = p0[0];
#pragma unroll
        for (int r = 0; r < 16; ++r) mt_ = __builtin_amdgcn_fmed3f(mt_, p0[r], __builtin_inff()), mt_ = __builtin_amdgcn_fmed3f(mt_, p1[r], __builtin_inff());
        mt_ = fmaxf(mt_, __shfl_xor(mt_, 32));
        if (__any(mt_ > mrun + 8.f)) {
            const float mnew = fmaxf(mrun, mt_), alpha = fexp2(mrun - mnew); mrun = mnew;
            lrun *= alpha;
#pragma unroll
            for (int mt = 0; mt < 4; ++mt)
#pragma unroll
                for (int r = 0; r < 16; ++r) o[mt][r] *= alpha;
        }
        float ps = 0.f;
#pragma unroll
        for (int r = 0; r < 16; ++r) { const int bp = (r & 3) + 8 * (r >> 2);
            const float e0 = fexp2(p0[r] - mrun), e1 = fexp2(p1[r] - mrun);
            p0[r] = __builtin_bit_cast(float, __builtin_bit_cast(unsigned, e0) & (unsigned)__builtin_amdgcn_sbfe((int)w0, bp, 1));
            p1[r] = __builtin_bit_cast(float, __builtin_bit_cast(unsigned, e1) & (unsigned)__builtin_amdgcn_sbfe((int)w1, bp, 1));
            ps += p0[r] + p1[r]; }
        lrun += ps;
        bf16x8 pb[4];
#pragma unroll
        for (int c = 0; c < 4; ++c) {
            u32x4 w;
            if (c < 2) { w.x = pkbf(p0[8 * c], p0[8 * c + 1]); w.y = pkbf(p0[8 * c + 2], p0[8 * c + 3]); w.z = pkbf(p0[8 * c + 4], p0[8 * c + 5]); w.w = pkbf(p0[8 * c + 6], p0[8 * c + 7]); }
            else { const int cc = c - 2; w.x = pkbf(p1[8 * cc], p1[8 * cc + 1]); w.y = pkbf(p1[8 * cc + 2], p1[8 * cc + 3]); w.z = pkbf(p1[8 * cc + 4], p1[8 * cc + 5]); w.w = pkbf(p1[8 * cc + 6], p1[8 * cc + 7]); }
            pb[c] = __builtin_bit_cast(bf16x8, w);
        }
        const unsigned vb = (unsigned)(size_t)(Vl + buf * AT_VB) + vlane;
#define AT_RD(S, MT) { S[0] = tr_read<(0) * AT_VP + 64 * (MT)>(vb); S[1] = tr_read<(8) * AT_VP + 64 * (MT)>(vb); S[2] = tr_read<(16) * AT_VP + 64 * (MT)>(vb); S[3] = tr_read<(24) * AT_VP + 64 * (MT)>(vb); \
            S[4] = tr_read<(32) * AT_VP + 64 * (MT)>(vb); S[5] = tr_read<(40) * AT_VP + 64 * (MT)>(vb); S[6] = tr_read<(48) * AT_VP + 64 * (MT)>(vb); S[7] = tr_read<(56) * AT_VP + 64 * (MT)>(vb); }
#define AT_WAIT(S, N) asm volatile("s_waitcnt lgkmcnt(" #N ")" : "+v"(S[0]), "+v"(S[1]), "+v"(S[2]), "+v"(S[3]), "+v"(S[4]), "+v"(S[5]), "+v"(S[6]), "+v"(S[7]) :: "memory")
#define AT_MM(S, MT) { o[MT] = MFMA32(cat8(S[0], S[1]), pb[0], o[MT]); o[MT] = MFMA32(cat8(S[2], S[3]), pb[1], o[MT]); o[MT] = MFMA32(cat8(S[4], S[5]), pb[2], o[MT]); o[MT] = MFMA32(cat8(S[6], S[7]), pb[3], o[MT]); }
        {   s16x4 va[8], vc[8];
            AT_RD(va, 0) AT_RD(vc, 1) AT_WAIT(va, 8); AT_MM(va, 0)
            AT_RD(va, 2) AT_WAIT(vc, 8); AT_MM(vc, 1)
            AT_RD(vc, 3) AT_WAIT(va, 8); AT_MM(va, 2)
            AT_WAIT(vc, 0); AT_MM(vc, 3)
        }
#undef AT_RD
#undef AT_WAIT
#undef AT_MM
        if (tile + 1 < ntiles) {
            LAS unsigned char* Kn = Kl + (buf ^ 1) * AT_KB; LAS unsigned char* Vn = Vl + (buf ^ 1) * AT_VB;
            *(LAS u32x4*)(Kn + srow * AT_KP + sch * 32) = sk0; *(LAS u32x4*)(Kn + srow * AT_KP + sch * 32 + 16) = sk1;
            *(LAS u32x4*)(Vn + srow * AT_VP + sch * 32) = sv0; *(LAS u32x4*)(Vn + srow * AT_VP + sch * 32 + 16) = sv1;
        }
        lds_barrier();
    }
    lrun += __shfl_xor(lrun, 32);
    const float inv = 1.0f / lrun;
    bf16* op = OA + rowq * DM + head * 128 + 4 * hi;
#pragma unroll
    for (int mt = 0; mt < 4; ++mt)
#pragma unroll
        for (int g4 = 0; g4 < 4; ++g4) { const f32x4 v = (f32x4){o[mt][4 * g4], o[mt][4 * g4 + 1], o[mt][4 * g4 + 2], o[mt][4 * g4 + 3]} * inv; *(u32x2*)(op + 32 * mt + 8 * g4) = pk4(v); }
}
__device__ __forceinline__ void attn_phase(const P& p, LAS unsigned char* lds, int qsel) {
    unsigned* qhead = (unsigned*)(p.ws + WS_CTL + 49152 + qsel * 256);
    volatile LAS unsigned* slot = (volatile LAS unsigned*)(lds + LDS_MISC + 64);
    const int tid = otid();
    for (;;) {
        __syncthreads();
        if (tid == 0) *slot = __hip_atomic_fetch_add(qhead, 1u, __ATOMIC_RELAXED, __HIP_MEMORY_SCOPE_AGENT);
        __syncthreads();
        const unsigned u = *slot;
        if (u >= 512u) break;
        const int bk = (int)(u & 15u), qb = 31 - (int)(u >> 4);
        attn_unit(p, lds, bk >> 2, bk & 3, qb);
    }
}

__device__ __forceinline__ void smp_scores_item(const P& p, LAS unsigned char* lds, int item) {
    const int tid = otid();
    const float* QIS = (const float*)(p.ws + WS_QIS); const float* WIDX = (const float*)(p.ws + WS_WIDX); float* SCS = (float*)(p.ws + WS_SCS);
    LAS float* ql = (LAS float*)lds;
    {
        const bool isnew = item >= 256; const int d = isnew ? item - 256 : item >> 5;
        const float* krow;
        int kidx;
        if (!isnew) { const int pg = (item & 31) * 4 + (tid >> 7); krow = p.cache_ik + ((size_t)p.page_table[d * 128 + pg] * 128 + (tid & 127)) * 64; kidx = pg * 128 + (tid & 127); }
        else { krow = p.out + O_IKS + (size_t)d * 64; kidx = PAST; }
        f32x4 kv[16];
#pragma unroll
        for (int c = 0; c < 16; ++c) kv[c] = __builtin_nontemporal_load((const f32x4*)(krow + c * 4));
        lds_barrier();
        for (int c = tid; c < 1024; c += 512) ql[c] = QIS[(size_t)d * 1024 + c];
        if (tid < 16) ql[1024 + tid] = WIDX[(size_t)(MP + d) * 16 + tid];
        lds_barrier();
        float sc = 0.f;
#pragma unroll 2
        for (int h = 0; h < 16; ++h) { float dot = 0.f;
#pragma unroll
            for (int c = 0; c < 16; ++c) { const f32x4 qv = *(const LAS f32x4*)(ql + h * 64 + c * 4); dot += (kv[c][0] * qv[0] + kv[c][1] * qv[1]) + (kv[c][2] * qv[2] + kv[c][3] * qv[3]); }
            sc += ql[1024 + h] * fmaxf(dot, 0.f); }
        if (!isnew || tid == 0) SCS[(size_t)d * 16640 + kidx] = sc;
    }
}
__device__ __forceinline__ void smp_select_item(const P& p, LAS unsigned char* lds, int item) {
    const int tid = otid(), lane = tid & 63, wid = tid >> 6;
    const float* SCS = (const float*)(p.ws + WS_SCS); int* SELS = (int*)(p.ws + WS_SELS);
    LAS int* cnts = (LAS int*)lds;
    LAS int* nsel = cnts + 16;
    {   const int d = item >> 2;
        __syncthreads();
        unsigned u[33];
#pragma unroll
        for (int i = 0; i < 33; ++i) { const int k = i * 512 + tid; const float sv = SCS[(size_t)d * 16640 + (k < 16640 ? k : 16639)]; u[i] = (k <= PAST) ? ord_u32(sv) : 0u; }
        if (tid == 0) *nsel = 0;
        unsigned tau = 0u;
        for (int bit = 31; bit >= 0; --bit) {
            const unsigned cand = tau | (1u << bit); int c = 0;
#pragma unroll
            for (int i = 0; i < 33; ++i) c += (u[i] >= cand) ? 1 : 0;
#pragma unroll
            for (int o = 1; o < 64; o <<= 1) c += __shfl_xor(c, o);
            LAS int* cb = cnts + (bit & 1) * 8;
            if (lane == 0) cb[wid] = c;
            __syncthreads();
            int tot = 0;
#pragma unroll
            for (int w = 0; w < 8; ++w) tot += cb[w];
            if (tot >= 256) tau = cand;
            if (tot == 256) break;
        }
        __syncthreads();
#pragma unroll
        for (int i = 0; i < 33; ++i) if (u[i] >= tau) { const int pos = atomicAdd((int*)nsel, 1); if (pos < 256) SELS[item * 256 + pos] = i * 512 + tid; }
        __syncthreads();
    }
}
__device__ __forceinline__ void smp_attn_item(const P& p, LAS unsigned char* lds, int item) {
    const int tid = otid(), lane = tid & 63, wid = tid >> 6;
    const bf16* Q = (const bf16*)(p.ws + WS_Q); const int* SELS = (const int*)(p.ws + WS_SELS); bf16* OA = (bf16*)(p.ws + WS_OA);
    LAS float* ql = (LAS float*)lds;
    LAS float* sc = ql + 512;
    LAS float* red = sc + 1024;
    LAS int* rofs = (LAS int*)(red + 2048);
    {   const int d = item >> 2, kvh = item & 3;
        __syncthreads();
        ql[tid] = bf2f(Q[(size_t)(MP + d) * DM + kvh * 512 + tid]);
        if (tid < 256) { const int idx = SELS[item * 256 + tid]; rofs[tid] = (idx < PAST) ? p.page_table[d * 128 + (idx >> 7)] * 128 + (idx & 127) : -1; }
        __syncthreads();
        {   const int j = tid >> 1, hf = tid & 1, ro = rofs[j];
            const float* kr = (ro >= 0) ? p.cache_k + ((size_t)ro * 4 + kvh) * 128 : p.out + O_KS + ((size_t)d * 4 + kvh) * 128;
            f32x4 kv[16];
#pragma unroll
            for (int c = 0; c < 16; ++c) kv[c] = __builtin_nontemporal_load((const f32x4*)(kr + hf * 64 + c * 4));
#pragma unroll
            for (int g = 0; g < 4; ++g) { float dot = 0.f;
#pragma unroll
                for (int c = 0; c < 16; ++c) { const f32x4 qv = *(const LAS f32x4*)(ql + g * 128 + hf * 64 + c * 4); dot += (kv[c][0] * qv[0] + kv[c][1] * qv[1]) + (kv[c][2] * qv[2] + kv[c][3] * qv[3]); }
                dot += __shfl_xor(dot, 1);
                if (hf == 0) sc[g * 256 + j] = dot; }
        }
        __syncthreads();
        if (wid < 4) { float v[4]; float mx = -INFINITY;
#pragma unroll
            for (int e = 0; e < 4; ++e) { v[e] = sc[wid * 256 + e * 64 + lane]; mx = fmaxf(mx, v[e]); }
#pragma unroll
            for (int o = 1; o < 64; o <<= 1) mx = fmaxf(mx, __shfl_xor(mx, o));
            float sm = 0.f;
#pragma unroll
            for (int e = 0; e < 4; ++e) { v[e] = fexp2(v[e] - mx); sm += v[e]; }
            sm = wave_sum(sm); const float inv = 1.0f / sm;
#pragma unroll
            for (int e = 0; e < 4; ++e) sc[wid * 256 + e * 64 + lane] = v[e] * inv; }
        __syncthreads();
        {   const int dd = tid & 127, jg = tid >> 7; float acc[4] = {0.f, 0.f, 0.f, 0.f};
#pragma unroll 1
            for (int j0 = 0; j0 < 64; j0 += 16) {
                float vv[16];
#pragma unroll
                for (int e = 0; e < 16; ++e) { const int ro = rofs[jg * 64 + j0 + e];
                    const float* vr = (ro >= 0) ? p.cache_v + ((size_t)ro * 4 + kvh) * 128 : p.out + O_VS + ((size_t)d * 4 + kvh) * 128;
                    vv[e] = __builtin_nontemporal_load(vr + dd); }
#pragma unroll
                for (int e = 0; e < 16; ++e)
#pragma unroll
                    for (int g = 0; g < 4; ++g) acc[g] += sc[g * 256 + jg * 64 + j0 + e] * vv[e];
            }
#pragma unroll
            for (int g = 0; g < 4; ++g) red[(jg * 4 + g) * 128 + dd] = acc[g];
        }
        __syncthreads();
        {   const int g = tid >> 7, dd = tid & 127;
            const float s = (red[(0 * 4 + g) * 128 + dd] + red[(1 * 4 + g) * 128 + dd]) + (red[(2 * 4 + g) * 128 + dd] + red[(3 * 4 + g) * 128 + dd]);
            OA[(size_t)(MP + d) * DM + (4 * kvh + g) * 128 + dd] = (bf16)(pkbf(s, 0.f) & 0xffffu); }
    }
}

#define MFMA16(a, b, c) __builtin_amdgcn_mfma_f32_16x16x32_bf16(a, b, c, 0, 0, 0)
constexpr size_t GW_ITEM = 73728, GW_WN = 0, GW_U = 16384, GW_QG = 32768, GW_KT = 49152, GW_QK = 65536;
constexpr int GW_SPLIT = 1290;
__device__ __forceinline__ unsigned char* gw_item(unsigned char* ws, int it) { return ws + (it < GW_SPLIT ? WS_H + (size_t)it * GW_ITEM : WS_X1 + (size_t)(it - GW_SPLIT) * GW_ITEM); }
constexpr size_t WS_GL = WS_CTL + 32768;
static_assert((size_t)GW_SPLIT * GW_ITEM <= (size_t)MPAD * DFF * 2 && (size_t)(2048 - GW_SPLIT) * GW_ITEM <= (size_t)MPAD * DM * 4, "GDN chunk records must fit in H and x1");
constexpr int G1_CW = 0, G1_GS = 6144, G1_BS = 6400, G1_KS = 6656, G1_QS = 24064, G1_RHS = 41472, G1_LB = 78336, G1_LD = 87552, G1_TB = 92672;
constexpr int G1_KP = 272, G1_RP = 576, G1_TP = 144;

__device__ __forceinline__ s16x4 tr_read_o(unsigned addr) { s16x4 r; asm volatile("ds_read_b64_tr_b16 %0, %1" : "=&v"(r) : "v"(addr) : "memory"); return r; }

constexpr int G1_NCH = 4;
__device__ __forceinline__ void g1_item(const P& p, LAS unsigned char* lds, int wg) {
    const int tid = otid(), lane = tid & 63, wid = tid >> 6, fr = lane & 15, fq = lane >> 4;
    const bf16* RAW = (const bf16*)(p.ws + WS_RAW);
    const float* GDEC = (const float*)(p.ws + WS_GDEC); const float* BETA = (const float*)(p.ws + WS_BETA);
    float* GLp = (float*)(p.ws + WS_GL);
    LAS float* GS = (LAS float*)(lds + G1_GS); LAS float* BS = (LAS float*)(lds + G1_BS);
    {
        const int h = wg & 15, b = (wg >> 4) & 3, cg0 = (wg >> 6) * G1_NCH;
        __syncthreads();
        for (int e = tid; e < 3 * 4 * 32; e += 512) { const int part = e / 128, rem = e % 128, j = rem >> 5, c4 = rem & 31;
            *(LAS f32x4*)(lds + G1_CW + ((part * 4 + j) * 128 + c4 * 4) * 4) = *(const f32x4*)(p.convw + (size_t)j * CONVD + part * 2048 + h * 128 + c4 * 4); }
        float g_nx = 0.f, b_nx = 0.f;
        if (wid == 0) { const int r0 = b * SEQ + cg0 * 64 + lane; g_nx = GDEC[(size_t)r0 * 16 + h]; b_nx = BETA[(size_t)r0 * 16 + h]; }
        u32x4 xa[4][2], xb[4][2], xc[4][2];
        const int t = tid >> 3, cg = tid & 7;
#define G1_LOADX(X, PART, C) { _Pragma("unroll") for (int j = 0; j < 4; ++j) { const int rr = (C) * 64 + t - 3 + j >= 0 ? b * SEQ + (C) * 64 + t - 3 + j : b * SEQ + (C) * 64 + t; \
                const bf16* xr = RAW + (size_t)rr * CONVD + (PART) * 2048 + h * 128 + cg * 16; X[j][0] = *(const u32x4*)xr; X[j][1] = *(const u32x4*)(xr + 8); } }
        for (int ci = 0; ci < G1_NCH; ++ci) {
            const int c = cg0 + ci, it = (b * 16 + h) * 32 + c;
            const int row0 = b * SEQ + c * 64;
            unsigned char* gw = gw_item(p.ws, it);
            const int trow = c * 64 + t;
            G1_LOADX(xa, 0, c) G1_LOADX(xb, 1, c) G1_LOADX(xc, 2, c)
            lds_barrier();
            if (wid == 0) {
                float g = g_nx; const float bb = b_nx;
                if (ci + 1 < G1_NCH) { g_nx = GDEC[(size_t)(row0 + 64 + lane) * 16 + h]; b_nx = BETA[(size_t)(row0 + 64 + lane) * 16 + h]; }
#pragma unroll
                for (int o = 1; o < 64; o <<= 1) { const float v = __shfl_up(g, o); if (lane >= o) g += v; }
                GS[lane] = g; BS[lane] = bb;
                if (lane == 63) GLp[it] = __expf(g);
            }
            lds_barrier();
            {
                const float bt = BS[t], Gt = GS[t], eG = __expf(Gt), eGl = __expf(GS[63] - Gt);
                f32x4 s[3][4];
#define G1_CONV(X, PART) { f32x4 y[4]; _Pragma("unroll") for (int q = 0; q < 4; ++q) y[q] = (f32x4){0.f, 0.f, 0.f, 0.f}; \
                    _Pragma("unroll") for (int j = 0; j < 4; ++j) { const float on = (trow - 3 + j >= 0) ? 1.f : 0.f; \
                        const LAS f32x4* wv = (const LAS f32x4*)(lds + G1_CW + (((PART) * 4 + j) * 128 + cg * 16) * 4); \
                        y[0] += wv[0] * on * unpk4((u32x2){X[j][0].x, X[j][0].y}); y[1] += wv[1] * on * unpk4((u32x2){X[j][0].z, X[j][0].w}); \
                        y[2] += wv[2] * on * unpk4((u32x2){X[j][1].x, X[j][1].y}); y[3] += wv[3] * on * unpk4((u32x2){X[j][1].z, X[j][1].w}); } \
                    float ss = 0.f; \
                    _Pragma("unroll") for (int q = 0; q < 4; ++q) { s[PART][q] = silu4(y[q]); ss += (s[PART][q][0] * s[PART][q][0] + s[PART][q][1] * s[PART][q][1]) + (s[PART][q][2] * s[PART][q][2] + s[PART][q][3] * s[PART][q][3]); } \
                    if ((PART) < 2) { ss += __shfl_xor(ss, 1); ss += __shfl_xor(ss, 2); ss += __shfl_xor(ss, 4); \
                        const float sc = (1.0f / sqrtf(ss + 1e-6f)) * ((PART) == 0 ? 0.08838834764831845f : 1.f); \
                        _Pragma("unroll") for (int q = 0; q < 4; ++q) s[PART][q] = s[PART][q] * sc; } }
                G1_CONV(xa, 0)
                G1_CONV(xb, 1)
                G1_CONV(xc, 2)
#undef G1_CONV
#define G1_PK16(dst, v, sc) { u32x4 w0, w1; w0.x = pkbf(v[0][0] * (sc), v[0][1] * (sc)); w0.y = pkbf(v[0][2] * (sc), v[0][3] * (sc)); w0.z = pkbf(v[1][0] * (sc), v[1][1] * (sc)); w0.w = pkbf(v[1][2] * (sc), v[1][3] * (sc)); \
                    w1.x = pkbf(v[2][0] * (sc), v[2][1] * (sc)); w1.y = pkbf(v[2][2] * (sc), v[2][3] * (sc)); w1.z = pkbf(v[3][0] * (sc), v[3][1] * (sc)); w1.w = pkbf(v[3][2] * (sc), v[3][3] * (sc)); \
                    *(dst) = w0; *((dst) + 1) = w1; }
                G1_PK16((LAS u32x4*)(lds + G1_QS + t * G1_KP + cg * 32), s[0], 1.f)
                G1_PK16((LAS u32x4*)(lds + G1_KS + t * G1_KP + cg * 32), s[1], 1.f)
                G1_PK16((LAS u32x4*)(lds + G1_RHS + t * G1_RP + cg * 32), s[2], bt)
                G1_PK16((LAS u32x4*)(lds + G1_RHS + t * G1_RP + 256 + cg * 32), s[1], bt * eG)
                G1_PK16((u32x4*)(gw + GW_QG + t * 256 + cg * 32), s[0], eG)
                G1_PK16((u32x4*)(gw + GW_KT + t * 256 + cg * 32), s[1], eGl)
#undef G1_PK16
#undef G1_LOADX
            }
            lds_barrier();
            for (int job = wid; job < 20; job += 8) {
                const bool isqk = job >= 10; const int jj = isqk ? job - 10 : job;
                int hiT = 0, loT = 0;
                if (jj >= 6) { hiT = 3; loT = jj - 6; } else if (jj >= 3) { hiT = 2; loT = jj - 3; } else if (jj >= 1) { hiT = 1; loT = jj - 1; }
                const LAS unsigned char* Ab = lds + G1_KS + (16 * loT + fr) * G1_KP + fq * 16;
                const LAS unsigned char* Bb = lds + (isqk ? G1_QS : G1_KS) + (16 * hiT + fr) * G1_KP + fq * 16;
                f32x4 d = {0.f, 0.f, 0.f, 0.f};
#pragma unroll
                for (int kk = 0; kk < 4; ++kk) d = MFMA16(*(const LAS bf16x8*)(Ab + kk * 64), *(const LAS bf16x8*)(Bb + kk * 64), d);
                const int i = 16 * hiT + fr; const float Gi = GS[i]; f32x4 o;
                if (!isqk) {
                    const float bi = BS[i];
#pragma unroll
                    for (int r = 0; r < 4; ++r) { const int j = 16 * loT + 4 * fq + r; o[r] = (i > j) ? bi * d[r] * __expf(Gi - GS[j]) : 0.f; }
                    *(LAS u32x2*)(lds + G1_LB + i * G1_TP + (16 * loT + 4 * fq) * 2) = pk4(o);
                    if (hiT == loT) *(LAS f32x4*)(lds + G1_LD + ((hiT * 16 + fr) * 20 + 4 * fq) * 4) = o;
                } else {
#pragma unroll
                    for (int r = 0; r < 4; ++r) { const int j = 16 * loT + 4 * fq + r; o[r] = (i >= j) ? d[r] * __expf(Gi - GS[j]) : 0.f; }
                    *(u32x2*)(gw + GW_QK + i * 128 + (16 * loT + 4 * fq) * 2) = pk4(o);
                }
            }
            if (tid < 384) { const int tp = tid >> 6, l2 = tid & 63;
                int iT = 0, jT = 1; if (tp == 1) jT = 2; else if (tp == 2) jT = 3; else if (tp == 3) { iT = 1; jT = 2; } else if (tp == 4) { iT = 1; jT = 3; } else if (tp == 5) { iT = 2; jT = 3; }
                *(u32x2*)(gw + GW_QK + (16 * iT + (l2 & 15)) * 128 + (16 * jT + 4 * (l2 >> 4)) * 2) = (u32x2){0u, 0u}; }
            lds_barrier();
            if (wid == 0) {
                const int blk = lane >> 4, i = lane & 15;
                const LAS float* ld = (const LAS float*)(lds + G1_LD + blk * 16 * 20 * 4);
                float T[16];
                T[15] = (i == 15) ? 1.f : 0.f;
#pragma unroll
                for (int j = 14; j >= 0; --j) {
                    float a = (i == j) ? 1.f : 0.f;
#pragma unroll
                    for (int k = j + 1; k < 16; ++k) a -= T[k] * ld[k * 20 + j];
                    T[j] = a;
                }
                u32x4 w0, w1; w0.x = pkbf(T[0], T[1]); w0.y = pkbf(T[2], T[3]); w0.z = pkbf(T[4], T[5]); w0.w = pkbf(T[6], T[7]);
                w1.x = pkbf(T[8], T[9]); w1.y = pkbf(T[10], T[11]); w1.z = pkbf(T[12], T[13]); w1.w = pkbf(T[14], T[15]);
                *(LAS u32x4*)(lds + G1_TB + lane * 32) = w0; *(LAS u32x4*)(lds + G1_TB + lane * 32 + 16) = w1;
            }
            lds_barrier();
            {
                typedef short s4 __attribute__((ext_vector_type(4)));
                s4 aT[4], aL[6];
#pragma unroll
                for (int bq = 0; bq < 4; ++bq) aT[bq] = *(const LAS s4*)(lds + G1_TB + (bq * 16 + fr) * 32 + fq * 8);
#pragma unroll
                for (int ib = 1; ib < 4; ++ib)
#pragma unroll
                    for (int jb = 0; jb < ib; ++jb) { u32x2 w = *(const LAS u32x2*)(lds + G1_LB + (16 * ib + fr) * G1_TP + (16 * jb + 4 * fq) * 2);
                        w.x ^= 0x80008000u; w.y ^= 0x80008000u; aL[ib * (ib - 1) / 2 + jb] = __builtin_bit_cast(s4, w); }
#pragma unroll
                for (int ct = 0; ct < 2; ++ct) {
                    const int c0 = 32 * wid + 16 * ct;
                    LAS unsigned char* rb = lds + G1_RHS + (4 * fq) * G1_RP + (c0 + fr) * 2;
                    s4 xb[3];
#pragma unroll
                    for (int ib = 0; ib < 4; ++ib) {
                        f32x4 acc;
#pragma unroll
                        for (int r = 0; r < 4; ++r) acc[r] = bf2f(*(const LAS unsigned short*)(rb + (16 * ib + r) * G1_RP));
#pragma unroll
                        for (int jb = 0; jb < ib; ++jb) acc = __builtin_amdgcn_mfma_f32_16x16x16bf16_1k(aL[ib * (ib - 1) / 2 + jb], xb[jb], acc, 0, 0, 0);
                        const s4 ab = __builtin_bit_cast(s4, pk4(acc));
                        const f32x4 x = __builtin_amdgcn_mfma_f32_16x16x16bf16_1k(aT[ib], ab, (f32x4){0.f, 0.f, 0.f, 0.f}, 0, 0, 0);
                        const u32x2 xp = pk4(x);
                        if (ib < 3) xb[ib] = __builtin_bit_cast(s4, xp);
                        if (c0 < 128) {
                            *(u32x2*)(gw + GW_U + (size_t)(((c0 >> 4) * 4 + ib) * 64 + lane) * 8) = xp;
                        } else {
                            const u32x2 xs = pk4(-x);
                            *(LAS unsigned short*)(rb + (16 * ib + 0) * G1_RP) = (unsigned short)(xs.x & 0xffffu); *(LAS unsigned short*)(rb + (16 * ib + 1) * G1_RP) = (unsigned short)(xs.x >> 16);
                            *(LAS unsigned short*)(rb + (16 * ib + 2) * G1_RP) = (unsigned short)(xs.y & 0xffffu); *(LAS unsigned short*)(rb + (16 * ib + 3) * G1_RP) = (unsigned short)(xs.y >> 16);
                        }
                    }
                }
            }
            lds_barrier();
#pragma unroll
            for (int i4 = 0; i4 < 2; ++i4) { const int q = tid + 512 * i4, row = q >> 4, ch = q & 15;
                const u32x4 v = *(const LAS u32x4*)(lds + G1_RHS + row * G1_RP + 256 + ch * 16);
                *(u32x4*)(gw + GW_WN + row * 256 + ch * 16) = v; }
        }
    }
}

constexpr int SC_WN = 0, SC_QG = 17408, SC_KT = 34816, SC_QK = 52224, SC_U = 61440, SC_BUF = 77824, SC_P = 272, SC_QP = 144, SC_NLD = 18;
__device__ __forceinline__ void gdn_scan_stage(LAS unsigned char* buf, const u32x4 (&st)[SC_NLD], int lt) {
    LAS unsigned char* const b16 = buf + (lt >> 4) * SC_P + (lt & 15) * 16;
    LAS unsigned char* const bu = buf + SC_U + lt * 16;
    LAS unsigned char* const bq = buf + SC_QK + (lt >> 3) * SC_QP + (lt & 7) * 16;
#pragma unroll
    for (int i = 0; i < SC_NLD; ++i) {
        if (i < 4) *(LAS u32x4*)(b16 + SC_WN + 16 * i * SC_P) = st[i];
        else if (i < 8) *(LAS u32x4*)(bu + (i - 4) * 4096) = st[i];
        else if (i < 16) *(LAS u32x4*)(b16 + (i < 12 ? SC_QG : SC_KT) + 16 * (i & 3) * SC_P) = st[i];
        else *(LAS u32x4*)(bq + 32 * (i - 16) * SC_QP) = st[i]; }
}
__device__ __forceinline__ void gdn_scan_load(u32x4 (&st)[SC_NLD], const unsigned char* gw, int lt) {
#pragma unroll
    for (int i = 0; i < SC_NLD; ++i) st[i] = *(const u32x4*)(gw + (size_t)i * 4096 + (unsigned)(lt * 16));
}
#define SC_FRAG(dst, base, pitch, row, col) { const LAS unsigned char* a_ = (base) + (row) * (pitch) + (col) * 2; const u32x2 x0_ = *(const LAS u32x2*)a_, x1_ = *(const LAS u32x2*)(a_ + 32); dst = (u32x4){x0_.x, x0_.y, x1_.x, x1_.y}; }
__device__ __forceinline__ void gdn_scan_item(const P& p, LAS unsigned char* lds, int bh) {
    const int tid = otid(), lane = tid & 63, wid = tid >> 6, fr = lane & 15, fq = lane >> 4;
    const int b = bh >> 4, h = bh & 15;
    __syncthreads();
    if (wid >= 4) {
        const int lt = tid - 256;
        u32x4 sa[SC_NLD], sb[SC_NLD];
        gdn_scan_load(sa, gw_item(p.ws, bh * 32), lt);
        gdn_scan_load(sb, gw_item(p.ws, bh * 32 + 1), lt);
        gdn_scan_stage(lds, sa, lt);
        gdn_scan_load(sa, gw_item(p.ws, bh * 32 + 2), lt);
        lds_barrier();
#define SC_LSTEP(R, C) { if ((C) + 1 < 32) gdn_scan_stage(lds + (((C) + 1) & 1) * SC_BUF, R, lt); gdn_scan_load(R, gw_item(p.ws, bh * 32 + ((C) + 3 < 32 ? (C) + 3 : 31)), lt); lds_barrier(); }
#pragma unroll 1
        for (int c = 0; c < 32; c += 2) { SC_LSTEP(sb, c) SC_LSTEP(sa, c + 1) }
#undef SC_LSTEP
        return;
    }
    bf16* OB = (bf16*)(p.ws + WS_OB); const float* GLp = (const float*)(p.ws + WS_GL);
    const int dv0 = 32 * wid;
    f32x4 S[8][2];
#pragma unroll
    for (int m = 0; m < 8; ++m) { S[m][0] = (f32x4){0.f, 0.f, 0.f, 0.f}; S[m][1] = (f32x4){0.f, 0.f, 0.f, 0.f}; }
    int eglv = __builtin_bit_cast(int, GLp[bh * 32 + (lane & 31)]);
    asm volatile("s_waitcnt vmcnt(0)" : "+v"(eglv) :: "memory");
    lds_barrier();
#pragma unroll 1
    for (int c = 0; c < 32; ++c) {
        const float egl = __builtin_bit_cast(float, __builtin_amdgcn_readlane(eglv, c));
        const LAS unsigned char* buf = lds + (c & 1) * SC_BUF;
        bf16x8 bS[4][2];
#pragma unroll
        for (int kk = 0; kk < 4; ++kk)
#pragma unroll
            for (int dt = 0; dt < 2; ++dt) { u32x4 w; w.x = pkbf(S[2 * kk][dt][0], S[2 * kk][dt][1]); w.y = pkbf(S[2 * kk][dt][2], S[2 * kk][dt][3]);
                w.z = pkbf(S[2 * kk + 1][dt][0], S[2 * kk + 1][dt][1]); w.w = pkbf(S[2 * kk + 1][dt][2], S[2 * kk + 1][dt][3]); bS[kk][dt] = __builtin_bit_cast(bf16x8, w); }
        f32x4 vn[4][2], oo[4][2];
        u32x4 fa[4][2], fb[4][2];
        u32x2 un[4][2];
#pragma unroll
        for (int m = 0; m < 4; ++m)
#pragma unroll
            for (int dt = 0; dt < 2; ++dt) un[m][dt] = *(const LAS u32x2*)(buf + SC_U + (((2 * wid + dt) * 4 + m) * 64 + lane) * 8);
#pragma unroll
        for (int m = 0; m < 4; ++m)
#pragma unroll
            for (int k = 0; k < 2; ++k) SC_FRAG(fa[m][k], buf + SC_WN, SC_P, 16 * m + fr, 32 * k + 4 * fq)
#pragma unroll
        for (int m = 0; m < 4; ++m) { vn[m][0] = unpk4(un[m][0]); vn[m][1] = unpk4(un[m][1]); }
        __builtin_amdgcn_sched_barrier(0);
#pragma unroll
        for (int m = 0; m < 4; ++m)
#pragma unroll
            for (int k = 0; k < 2; ++k) SC_FRAG(fb[m][k], buf + SC_WN, SC_P, 16 * m + fr, 32 * (k + 2) + 4 * fq)
#pragma unroll
        for (int k = 0; k < 2; ++k)
#pragma unroll
            for (int m = 0; m < 4; ++m) { vn[m][0] = MFMA16(__builtin_bit_cast(bf16x8, fa[m][k]), bS[k][0], vn[m][0]); vn[m][1] = MFMA16(__builtin_bit_cast(bf16x8, fa[m][k]), bS[k][1], vn[m][1]); }
        __builtin_amdgcn_sched_barrier(0);
        const unsigned kl = (unsigned)(size_t)(buf + SC_KT) + (unsigned)((4 * fq + ((lane >> 2) & 3)) * SC_P + (lane & 3) * 8);
        s16x4 lo[4][2], hi4[4][2];
#pragma unroll
        for (int q = 0; q < 4; ++q)
#pragma unroll
            for (int k2 = 0; k2 < 2; ++k2) { lo[q][k2] = tr_read_o(kl + (32 * k2) * SC_P + q * 32); hi4[q][k2] = tr_read_o(kl + (32 * k2 + 16) * SC_P + q * 32); }
#pragma unroll
        for (int k = 0; k < 2; ++k)
#pragma unroll
            for (int m = 0; m < 4; ++m) { vn[m][0] = MFMA16(__builtin_bit_cast(bf16x8, fb[m][k]), bS[k + 2][0], vn[m][0]); vn[m][1] = MFMA16(__builtin_bit_cast(bf16x8, fb[m][k]), bS[k + 2][1], vn[m][1]); }
        asm volatile("s_waitcnt lgkmcnt(0)" : "+v"(lo[0][0]), "+v"(lo[0][1]), "+v"(lo[1][0]), "+v"(lo[1][1]), "+v"(lo[2][0]), "+v"(lo[2][1]), "+v"(lo[3][0]), "+v"(lo[3][1]),
                                              "+v"(hi4[0][0]), "+v"(hi4[0][1]), "+v"(hi4[1][0]), "+v"(hi4[1][1]), "+v"(hi4[2][0]), "+v"(hi4[2][1]), "+v"(hi4[3][0]), "+v"(hi4[3][1]) :: "memory");
        __builtin_amdgcn_sched_barrier(0);
        bf16x8 bV[2][2];
#pragma unroll
        for (int k2 = 0; k2 < 2; ++k2)
#pragma unroll
            for (int dt = 0; dt < 2; ++dt) { u32x4 w; w.x = pkbf(vn[2 * k2][dt][0], vn[2 * k2][dt][1]); w.y = pkbf(vn[2 * k2][dt][2], vn[2 * k2][dt][3]);
                w.z = pkbf(vn[2 * k2 + 1][dt][0], vn[2 * k2 + 1][dt][1]); w.w = pkbf(vn[2 * k2 + 1][dt][2], vn[2 * k2 + 1][dt][3]); bV[k2][dt] = __builtin_bit_cast(bf16x8, w); }
#pragma unroll
        for (int m = 0; m < 4; ++m)
#pragma unroll
            for (int k = 0; k < 2; ++k) SC_FRAG(fa[m][k], buf + SC_QG, SC_P, 16 * m + fr, 32 * k + 4 * fq)
#pragma unroll
        for (int q = 0; q < 4; ++q) { S[q][0] = S[q][0] * egl; S[q][1] = S[q][1] * egl;
#pragma unroll
            for (int k2 = 0; k2 < 2; ++k2) { const bf16x8 a = cat8(lo[q][k2], hi4[q][k2]); S[q][0] = MFMA16(a, bV[k2][0], S[q][0]); S[q][1] = MFMA16(a, bV[k2][1], S[q][1]); } }
        __builtin_amdgcn_sched_barrier(0);
#pragma unroll
        for (int q = 0; q < 4; ++q)
#pragma unroll
            for (int k2 = 0; k2 < 2; ++k2) { lo[q][k2] = tr_read_o(kl + (32 * k2) * SC_P + (4 + q) * 32); hi4[q][k2] = tr_read_o(kl + (32 * k2 + 16) * SC_P + (4 + q) * 32); }
        asm volatile("s_waitcnt lgkmcnt(0)" : "+v"(lo[0][0]), "+v"(lo[0][1]), "+v"(lo[1][0]), "+v"(lo[1][1]), "+v"(lo[2][0]), "+v"(lo[2][1]), "+v"(lo[3][0]), "+v"(lo[3][1]),
                                              "+v"(hi4[0][0]), "+v"(hi4[0][1]), "+v"(hi4[1][0]), "+v"(hi4[1][1]), "+v"(hi4[2][0]), "+v"(hi4[2][1]), "+v"(hi4[3][0]), "+v"(hi4[3][1]) :: "memory");
        __builtin_amdgcn_sched_barrier(0);
#pragma unroll
        for (int m = 0; m < 4; ++m)
#pragma unroll
            for (int k = 0; k < 2; ++k) SC_FRAG(fb[m][k], buf + SC_QG, SC_P, 16 * m + fr, 32 * (k + 2) + 4 * fq)
#pragma unroll
        for (int q = 0; q < 4; ++q) { S[4 + q][0] = S[4 + q][0] * egl; S[4 + q][1] = S[4 + q][1] * egl;
#pragma unroll
            for (int k2 = 0; k2 < 2; ++k2) { const bf16x8 a = cat8(lo[q][k2], hi4[q][k2]); S[4 + q][0] = MFMA16(a, bV[k2][0], S[4 + q][0]); S[4 + q][1] = MFMA16(a, bV[k2][1], S[4 + q][1]); } }
#pragma unroll
        for (int m = 0; m < 4; ++m) { oo[m][0] = (f32x4){0.f, 0.f, 0.f, 0.f}; oo[m][1] = (f32x4){0.f, 0.f, 0.f, 0.f}; }
#pragma unroll
        for (int k = 0; k < 2; ++k)
#pragma unroll
            for (int m = 0; m < 4; ++m) { oo[m][0] = MFMA16(bS[k][0], __builtin_bit_cast(bf16x8, fa[m][k]), oo[m][0]); oo[m][1] = MFMA16(bS[k][1], __builtin_bit_cast(bf16x8, fa[m][k]), oo[m][1]); }
        __builtin_amdgcn_sched_barrier(0);
#pragma unroll
        for (int m = 0; m < 4; ++m)
#pragma unroll
            for (int k = 0; k < 2; ++k) SC_FRAG(fa[m][k], buf + SC_QK, SC_QP, 16 * m + fr, 32 * k + 4 * fq)
#pragma unroll
        for (int k = 0; k < 2; ++k)
#pragma unroll
            for (int m = 0; m < 4; ++m) { oo[m][0] = MFMA16(bS[k + 2][0], __builtin_bit_cast(bf16x8, fb[m][k]), oo[m][0]); oo[m][1] = MFMA16(bS[k + 2][1], __builtin_bit_cast(bf16x8, fb[m][k]), oo[m][1]); }
        __builtin_amdgcn_sched_barrier(0);
#pragma unroll
        for (int k = 0; k < 2; ++k)
#pragma unroll
            for (int m = 0; m < 4; ++m) { oo[m][0] = MFMA16(bV[k][0], __builtin_bit_cast(bf16x8, fa[m][k]), oo[m][0]); oo[m][1] = MFMA16(bV[k][1], __builtin_bit_cast(bf16x8, fa[m][k]), oo[m][1]); }
        __builtin_amdgcn_sched_barrier(0);
#pragma unroll
        for (int m = 0; m < 4; ++m)
#pragma unroll
            for (int dt = 0; dt < 2; ++dt)
                *(u32x2*)(OB + (size_t)(b * SEQ + c * 64 + 16 * m + fr) * DM + h * 128 + dv0 + 16 * dt + 4 * fq) = pk4(oo[m][dt]);
        lds_barrier();
    }
    float* so = p.out + O_SSMP + (size_t)bh * 16384;
#pragma unroll
    for (int md = 0; md < 8; ++md)
#pragma unroll
        for (int dt = 0; dt < 2; ++dt)
#pragma unroll
            for (int r = 0; r < 4; ++r) so[(size_t)(16 * md + 4 * fq + r) * 128 + dv0 + 16 * dt + fr] = S[md][dt][r];
}
#undef SC_FRAG

enum { PH_PRO = 0, PH_GU1, PH_DN1, PH_WIN, PH_MIX1, PH_MIX3, PH_MRG, PH_WO, PH_GU2, PH_DN2, PH_LN3, PH_COUNT };

template <int PH> __device__ __forceinline__ void run_phase(const P& p, LAS unsigned char* lds) {
    unsigned char* ws = p.ws;
    if constexpr (PH == PH_PRO) p0_prologue(p, lds);
    float* const ST2 = (float*)(ws + CW_ST2);
    bf16* const PREB = (bf16*)(ws + WS_X1B);
    if constexpr (PH == PH_GU1) {
        pg8::Gemm g{(const bf16*)(ws + WS_XB), (const bf16*)(ws + WS_W1T), MPAD, NFF2, DM};
        pg8::StaticOrder S; S.init(MPAD, NFF2, gridDim.x, blockIdx.x);
        EpiSwiglu<false> E{(bf16*)(ws + WS_H), nullptr, nullptr, nullptr};
        pg8::gemm_phase<EpiSwiglu<false>, pg8::StaticOrder, true, true>(lds, g, S, E);
    }
    if constexpr (PH == PH_GU2) {
        pg8::Gemm g{PREB, (const bf16*)(ws + WS_W2T), MPAD, NFF2, DM};
        pg8::StaticOrder S; S.init(MPAD, NFF2, gridDim.x, blockIdx.x);
        EpiSwiglu<true> E{(bf16*)(ws + WS_H), ST2, (const float*)(ws + CW_CSGU), (const float*)(ws + CW_BBGU)};
        pg8::gemm_phase<EpiSwiglu<true>, pg8::StaticOrder, true, true>(lds, g, S, E);
    }
    if constexpr (PH == PH_DN1) {
        const bf16* Hh = (const bf16*)(ws + WS_H); const bf16* Wd = (const bf16*)(ws + WS_W1D);
        pg8::Gemm g{Hh, Wd, MP, DM, DFF};
        pg8::StaticOrder S; S.init(MP, DM, gridDim.x, blockIdx.x);
        EpiResid<0> E{ws, p.x_prompt, nullptr, nullptr, 0.5f};
        pg8::gemm_phase<EpiResid<0>, pg8::StaticOrder, true, true>(lds, g, S, E);
        skinny_phase<0>(Hh + (size_t)MP * DFF, Wd, DM, DFF, ws, p.x_sample, nullptr, nullptr, 0.5f, lds);
    }
    if constexpr (PH == PH_DN2) {
        const bf16* Hh = (const bf16*)(ws + WS_H); const bf16* Wd = (const bf16*)(ws + WS_W2D);
        pg8::Gemm g{Hh, Wd, MP, DM, DFF};
        pg8::StaticOrder S; S.init(MP, DM, gridDim.x, blockIdx.x);
        if (gridDim.x >= 256) {
            EpiLn3 E{ws, p.ln2g, p.ln2b, p.ln3g, p.ln3b, p.out + O_YP};
            pg8::gemm_phase<EpiLn3, pg8::StaticOrder, true, true>(lds, g, S, E);
        } else {
            EpiResid<2> E{ws, nullptr, p.ln2g, p.ln2b, 0.5f};
            pg8::gemm_phase<EpiResid<2>, pg8::StaticOrder, true, true>(lds, g, S, E);
        }
        skinny_phase<2>(Hh + (size_t)MP * DFF, Wd, DM, DFF, ws, nullptr, p.ln2g, p.ln2b, 0.5f, lds);
    }
    if constexpr (PH == PH_LN3) ln_phase((const float*)(ws + WS_PRE), p.ln3g, p.ln3b, p.out + O_YP, p.out + O_YS, nullptr, gridDim.x >= 256 ? MP : 0);
    if constexpr (PH == PH_WIN) {
        pg8::Gemm g{PREB, (const bf16*)(ws + WS_WIN), MPAD, NIN, DM};
        pg8::StaticOrder S; S.init(MPAD, NIN, gridDim.x, blockIdx.x);
        EpiWin E{ws, (unsigned char*)p.out};
        pg8::gemm_phase<EpiWin, pg8::StaticOrder, true, true>(lds, g, S, E);
    }
#ifndef PROBE_SUB
#define PROBE_SUB 0
#endif
    if constexpr (PH == PH_MIX1) {
        unsigned* qhead = (unsigned*)(ws + WS_CTL + 49152 + 512);
        volatile LAS unsigned* slot = (volatile LAS unsigned*)(lds + LDS_MISC + 64);
        constexpr unsigned Q_G1 = 256, Q_SMP = Q_G1 + 2048 / G1_NCH, Q_CONV = Q_SMP + 264, Q_W2 = Q_CONV + 8, N_W2 = (32 * 176 + 88 * 32) / 8, Q_END = Q_W2 + N_W2;
        const int t_ = otid();
        for (;;) {
            __syncthreads();
            if (t_ == 0) *slot = __hip_atomic_fetch_add(qhead, 1u, __ATOMIC_RELAXED, __HIP_MEMORY_SCOPE_AGENT);
            __syncthreads();
            const unsigned u = *slot;
            if (u >= Q_END) break;
            if (u < Q_G1) idx_item(p, lds, (int)u);
            else if (u < Q_SMP) g1_item(p, lds, (int)(u - Q_G1));
            else if (u < Q_CONV) smp_scores_item(p, lds, (int)(u - Q_SMP));
            else if (u < Q_W2) conv_row(p, MP + (int)(u - Q_CONV));
            else convert_ffn2(p, (int)(u - Q_W2) * 8 + (t_ >> 6), 1 << 30, t_ & 63);
        }
    }
    if constexpr (PH == PH_MIX3) {
        const bool big = gridDim.x >= 128;
        for (int bh = blockIdx.x; bh < 64; bh += gridDim.x) { gdn_scan_item(p, lds, bh); if constexpr (PROBE_SUB == 4) gdn_scan_item(p, lds, bh); }
        for (int item = (int)blockIdx.x - (big ? 64 : 0); item >= 0 && item < 32; item += gridDim.x) { smp_select_item(p, lds, item); smp_attn_item(p, lds, item); }
        gdn_naive_phase(p, lds, big ? 96 : 0, big ? 32 : (int)gridDim.x);
        attn_phase(p, lds, 0);
        if constexpr (PROBE_SUB == 6) attn_phase(p, lds, 1);
    }
    if constexpr (PH == PH_MRG) merge_phase(p);
    if constexpr (PH == PH_WO) {
        const bf16* Mr = (const bf16*)(ws + WS_MRG); const bf16* Wo = (const bf16*)(ws + WS_WO);
        pg8::Gemm g{Mr, Wo, MP, DM, DM};
        pg8::StaticOrder S; S.init(MP, DM, gridDim.x, blockIdx.x);
        EpiResid<1> E{ws, nullptr, p.ln1g, p.ln1b, 1.0f};
        pg8::gemm_phase<EpiResid<1>, pg8::StaticOrder, true, true>(lds, g, S, E);
        skinny_phase<1>(Mr + (size_t)MP * DM, Wo, DM, DM, ws, nullptr, p.ln1g, p.ln1b, 1.0f, lds);
    }
}

#ifndef MK_MULTI
#define MK_MULTI 0
#endif
#if MK_MULTI
template <int PH> __global__ void __launch_bounds__(512, 2) k_phase(P p) {
    extern __shared__ __attribute__((aligned(16))) unsigned char lds_raw[];
    run_phase<PH>(p, (LAS unsigned char*)lds_raw);
}
template <int PH> static void launch_phase(const P& p, int grid, hipStream_t stream) {
    static bool attr_done = false;
    if (!attr_done) { (void)hipFuncSetAttribute((const void*)k_phase<PH>, hipFuncAttributeMaxDynamicSharedMemorySize, LDS_BYTES); attr_done = true; }
    hipLaunchKernelGGL(k_phase<PH>, dim3(grid), dim3(512), LDS_BYTES, stream, p);
    hipError_t e = hipGetLastError();
    if (e != hipSuccess) fprintf(stderr, "kernel_launch: phase %d launch failed: %s\n", PH, hipGetErrorName(e));
}
#else
__global__ void __launch_bounds__(512, 2) k_fwd(P p) {
    extern __shared__ __attribute__((aligned(16))) unsigned char lds_raw[];
    LAS unsigned char* lds = (LAS unsigned char*)lds_raw;
    volatile LAS unsigned* misc = (volatile LAS unsigned*)(lds + LDS_MISC);
    if (threadIdx.x < 4) misc[threadIdx.x] = 0u;
    __syncthreads();
    XcdBarrier bar = xcd_barrier_post((unsigned*)(p.ws + WS_CTL), misc);
#ifndef PROBE_DOUBLE
#define PROBE_DOUBLE -1
#endif
#define RUNP(PH) { run_phase<PH>(p, lds); xcd_barrier(bar); if constexpr (PROBE_DOUBLE == PH) { run_phase<PH>(p, lds); xcd_barrier(bar); } }
    RUNP(PH_PRO) RUNP(PH_GU1) RUNP(PH_DN1) RUNP(PH_WIN) RUNP(PH_MIX1) RUNP(PH_MIX3) RUNP(PH_MRG) RUNP(PH_WO) RUNP(PH_GU2) RUNP(PH_DN2)
    run_phase<PH_LN3>(p, lds);
#undef RUNP
}
#endif

extern "C" void kernel_launch(void* const* d_in, const int* in_sizes, int n_in, void* d_out, int out_size, void* d_ws, size_t ws_size, hipStream_t stream) {
    if (n_in != 26 || out_size != (int)O_END || ws_size < WS_END) { fprintf(stderr, "kernel_launch: unexpected shapes: n_in %d out_size %d ws_size %zu (need %zu)\n", n_in, out_size, ws_size, (size_t)WS_END); return; }
    P p{};
    p.x_prompt = (const float*)d_in[0]; p.x_sample = (const float*)d_in[1]; p.cache_k = (const float*)d_in[2]; p.cache_v = (const float*)d_in[3]; p.cache_ik = (const float*)d_in[4];
    p.state_ssm = (const float*)d_in[5]; p.state_conv = (const float*)d_in[6]; p.page_table = (const int*)d_in[7];
    p.w1g = (const float*)d_in[8]; p.w1u = (const float*)d_in[9]; p.w1d = (const float*)d_in[10]; p.ln1g = (const float*)d_in[11]; p.ln1b = (const float*)d_in[12];
    p.win = (const float*)d_in[13]; p.convw = (const float*)d_in[14]; p.alog = (const float*)d_in[15]; p.dtb = (const float*)d_in[16]; p.gng = (const float*)d_in[17];
    p.wo = (const float*)d_in[18]; p.ln2g = (const float*)d_in[19]; p.ln2b = (const float*)d_in[20]; p.w2g = (const float*)d_in[21]; p.w2u = (const float*)d_in[22]; p.w2d = (const float*)d_in[23];
    p.ln3g = (const float*)d_in[24]; p.ln3b = (const float*)d_in[25];
    p.out = (float*)d_out; p.ws = (unsigned char*)d_ws;
    static int grid = 0;
    if (!grid) { int dev = 0, cus = 0; (void)hipGetDevice(&dev); (void)hipDeviceGetAttribute(&cus, hipDeviceAttributeMultiprocessorCount, dev); grid = cus > 0 ? cus : 256; }
    (void)hipMemsetAsync((char*)d_ws + WS_CTL, 0, CTL_BYTES, stream);
#if MK_MULTI
    launch_phase<PH_PRO>(p, grid, stream); launch_phase<PH_GU1>(p, grid, stream); launch_phase<PH_DN1>(p, grid, stream);
    launch_phase<PH_WIN>(p, grid, stream); launch_phase<PH_MIX1>(p, grid, stream); launch_phase<PH_MIX3>(p, grid, stream);
    launch_phase<PH_MRG>(p, grid, stream); launch_phase<PH_WO>(p, grid, stream); launch_phase<PH_GU2>(p, grid, stream);
    launch_phase<PH_DN2>(p, grid, stream); launch_phase<PH_LN3>(p, grid, stream);
#else
    static bool attr_done = false;
    if (!attr_done) {
        (void)hipFuncSetAttribute((const void*)k_fwd, hipFuncAttributeMaxDynamicSharedMemorySize, LDS_BYTES);
        int per_cu = 0;
        if (hipOccupancyMaxActiveBlocksPerMultiprocessor(&per_cu, (const void*)k_fwd, 512, LDS_BYTES) != hipSuccess || per_cu < 1)
            fprintf(stderr, "kernel_launch: occupancy query reports %d workgroups per CU for k_fwd (need 1)\n", per_cu);
        attr_done = true;
    }
    hipLaunchKernelGGL(k_fwd, dim3(grid), dim3(512), LDS_BYTES, stream, p);
    hipError_t e = hipGetLastError();
    if (e != hipSuccess) fprintf(stderr, "kernel_launch: launch failed: %s\n", hipGetErrorName(e));
#endif
}
```

```cpp
#include <hip/hip_runtime.h>
#include <cstdio>
#include <cstdint>
__device__ __forceinline__ int otid() { int t = (int)threadIdx.x; asm volatile("" : "+v"(t)); return t; }
namespace pg8 {
#define PG8_LAS __attribute__((address_space(3)))
typedef unsigned short bf16_t;
typedef short bf16x8 __attribute__((ext_vector_type(8)));
typedef float f32x4 __attribute__((ext_vector_type(4)));
typedef unsigned u32x4 __attribute__((ext_vector_type(4)));
constexpr int BM = 256, BK = 64, HALF = 128, HTB = HALF * BK * 2  , STAGE_BYTES = 8 * HTB, NXCD = 8, WGM = 8;

__host__ __device__ __forceinline__ int lds_byte(int r, int c) { const int st = (r >> 4) * 2 + (c >> 5), rr = r & 15, cc = c & 31, ob = rr * 64 + cc * 2; return st * 1024 + (ob ^ (((ob >> 9) & 1) << 5)); }
__host__ __device__ __forceinline__ void stage_rc(int b, int& R, int& C) { const int st = b / 1024, sb = b % 1024, swz = sb ^ (((sb >> 9) & 1) << 5); R = (st >> 1) * 16 + swz / 64; C = (st & 1) * 32 + (swz % 64) / 2; }
__host__ __device__ __forceinline__ int perm32(int rho) { const int n = rho >> 4, i = rho & 15; return 8 * (i >> 2) + 4 * n + (i & 3); }

struct Unit { int pm, pn; };
struct Gemm { const bf16_t* A; const bf16_t* Bt; int M, N, K; };

struct StaticOrder {
    int nM, nN, nwg, G, c;
    __host__ __device__ void init(int M, int N, int G_, int c_) { nM = M / BM; nN = N / BM; nwg = nM * nN; G = G_; c = c_; }
    __host__ __device__ bool next(int i, Unit& u) const {
        const long L = (long)i * G + c; if (L >= nwg) return false;
        int wgid = (int)L; { const int q = nwg / NXCD, r = nwg % NXCD, xcd = wgid % NXCD, off = wgid / NXCD; wgid = (xcd < r ? xcd * (q + 1) : r * (q + 1) + (xcd - r) * q) + off; }
        const int nig = WGM * nN, gid = wgid / nig, fm = gid * WGM, gsz = (nM - fm) < WGM ? (nM - fm) : WGM;
        u.pm = fm + ((wgid % nig) % gsz); u.pn = (wgid % nig) / gsz; return true;
    }
    __device__ __forceinline__ void a_ready(const Unit&) const {}
    __device__ __forceinline__ void done(const Unit&) const {}
};

__device__ __forceinline__ unsigned cvt_pk_bf16(float lo, float hi) { unsigned r; asm volatile("v_cvt_pk_bf16_f32 %0, %1, %2" : "=v"(r) : "v"(lo), "v"(hi)); return r; }
template <class Epi, class Sched, bool ALIGN_EPI = false, bool SP2 = false>
__device__ __forceinline__ void gemm_phase(PG8_LAS unsigned char* lds, const Gemm g, const Sched& S, const Epi& E) {
    const int tid = otid(), wid = __builtin_amdgcn_readfirstlane(tid >> 6), lane = tid & 63, wr = wid >> 2, wc = wid & 3, fr = lane & 15, fq = lane >> 4;
    const int K = g.K, nt = K / BK;
    unsigned voffA[2], voffB[2];
#pragma unroll
    for (int i = 0; i < 2; ++i) { int R, C; stage_rc(tid * 16 + i * 8192, R, C); const int Rb = Epi::PERM ? ((R & ~31) + perm32(R & 31)) : R;
        voffA[i] = (unsigned)(R * K + C) * 2u; voffB[i] = (unsigned)(Rb * K + C) * 2u; }
    const size_t kstep = (size_t)(BK * 2);
    const size_t hstep = (size_t)HALF * K * 2;
    const size_t tstep = 2 * hstep;
    const unsigned ldsw = (unsigned)wid * 1024u;
    const int aoff = lds_byte(wr * 64 + fr, fq * 8), boff = lds_byte(wc * 32 + fr, fq * 8);
#define PG8_SA(b, h) (((b) * 2 + (h)) * HTB)
#define PG8_SB(b, h) ((4 + (b) * 2 + (h)) * HTB)
#define PG8_STAGE(bufoff, gbase, voff) do { _Pragma("unroll") for (int _i = 0; _i < 2; ++_i) \
        __builtin_amdgcn_global_load_lds((const unsigned*)((const char*)(gbase) + (voff)[_i]), (PG8_LAS unsigned*)(lds + (bufoff) + ldsw + _i * 8192), 16, 0, 0); } while (0)
#define PG8_LDA(dst, b, h) do { _Pragma("unroll") for (int m = 0; m < 4; ++m) _Pragma("unroll") for (int k = 0; k < 2; ++k) dst[m][k] = *(const PG8_LAS bf16x8*)(lds + PG8_SA(b, h) + aoff + m * 2048 + k * 1024); } while (0)
#define PG8_LDB(dst, b, h) do { _Pragma("unroll") for (int n = 0; n < 2; ++n) _Pragma("unroll") for (int k = 0; k < 2; ++k) dst[n][k] = *(const PG8_LAS bf16x8*)(lds + PG8_SB(b, h) + boff + n * 2048 + k * 1024); } while (0)
#define PG8_MMA(ai, bj, At, Bt) do { __builtin_amdgcn_s_setprio(1); _Pragma("unroll") for (int m = 0; m < 4; ++m) _Pragma("unroll") for (int n = 0; n < 2; ++n) _Pragma("unroll") for (int k = 0; k < 2; ++k) \
        acc[ai][bj][m][n] = __builtin_amdgcn_mfma_f32_16x16x32_bf16(Bt[n][k], At[m][k], acc[ai][bj][m][n], 0, 0, 0); __builtin_amdgcn_s_setprio(0); } while (0)
#define PG8_WAIT_V(n) asm volatile("s_waitcnt vmcnt(" #n ")" ::: "memory")
#define PG8_WAIT_L(n) asm volatile("s_waitcnt lgkmcnt(" #n ")" ::: "memory")
#define PG8_BAR __builtin_amdgcn_s_barrier()
#define PG8_SCHED __builtin_amdgcn_sched_barrier(0)
    Unit cur, nxt; int ui = 0;
    if (!S.next(0, cur)) return;
    f32x4 acc[2][2][4][2];
#pragma unroll
    for (int a = 0; a < 2; ++a)
#pragma unroll
        for (int b = 0; b < 2; ++b)
#pragma unroll
            for (int m = 0; m < 4; ++m)
#pragma unroll
                for (int n = 0; n < 2; ++n) acc[a][b][m][n] = (f32x4){0.f, 0.f, 0.f, 0.f};
    bf16x8 At[4][2], B0[2][2], B1[2][2];
    const char* cA = (const char*)g.A + (size_t)cur.pm * tstep; const char* cB = (const char*)g.Bt + (size_t)cur.pn * tstep;
    S.a_ready(cur);
    if constexpr (SP2) {
        PG8_STAGE(PG8_SB(0, 0), cB, voffB); PG8_STAGE(PG8_SB(0, 1), cB + hstep, voffB); PG8_STAGE(PG8_SA(0, 0), cA, voffA); PG8_STAGE(PG8_SA(0, 1), cA + hstep, voffA);
        if (wr == 1) PG8_BAR;
        PG8_WAIT_V(2); PG8_BAR;
        PG8_STAGE(PG8_SB(1, 0), cB + kstep, voffB); PG8_STAGE(PG8_SA(1, 0), cA + kstep, voffA); PG8_STAGE(PG8_SB(1, 1), cB + hstep + kstep, voffB);
        PG8_WAIT_V(6); PG8_BAR;
    } else {
        PG8_STAGE(PG8_SB(0, 0), cB, voffB); PG8_STAGE(PG8_SA(0, 0), cA, voffA); PG8_STAGE(PG8_SB(0, 1), cB + hstep, voffB); PG8_STAGE(PG8_SA(0, 1), cA + hstep, voffA);
        if (wr == 1) PG8_BAR;
        PG8_WAIT_V(4); PG8_BAR;
        PG8_STAGE(PG8_SB(1, 0), cB + kstep, voffB); PG8_STAGE(PG8_SA(1, 0), cA + kstep, voffA); PG8_STAGE(PG8_SB(1, 1), cB + hstep + kstep, voffB);
        PG8_WAIT_V(6); PG8_BAR;
    }
    for (;;) {
        const bool has_next = S.next(ui + 1, nxt);
        if constexpr (Epi::PF) {
            PG8_LAS unsigned char* ops = lds + STAGE_BYTES + (ui & 1) * 4096;
            const unsigned ln_ = __builtin_amdgcn_mbcnt_hi(~0u, __builtin_amdgcn_mbcnt_lo(~0u, 0u));
            __builtin_amdgcn_global_load_lds((const unsigned*)(E.pf_stats() + (size_t)cur.pm * 512 + wid * 64) + ln_, (PG8_LAS unsigned*)(ops + wid * 256), 4, 0, 0);
            __builtin_amdgcn_global_load_lds((const unsigned*)((wid < 4 ? E.pf_vec0() : E.pf_vec1()) + (size_t)cur.pn * 256 + (wid & 3) * 64) + ln_, (PG8_LAS unsigned*)(ops + 2048 + wid * 256), 4, 0, 0);
        }
        const char* nA = has_next ? (const char*)g.A + (size_t)nxt.pm * tstep : cA; const char* nB = has_next ? (const char*)g.Bt + (size_t)nxt.pn * tstep : cB;
        for (int t = 0; t < nt; t += 2) {
            const bool last = (t == nt - 2);
            const char* a1 = cA + (size_t)(t + 1) * kstep;
            const char* a2 = last ? nA : cA + (size_t)(t + 2) * kstep; const char* b2 = last ? nB : cB + (size_t)(t + 2) * kstep;
            const char* a3 = a2 + kstep; const char* b3 = b2 + kstep;
            if (last && has_next) S.a_ready(nxt);
            if constexpr (SP2) {
            PG8_LDB(B0, 0, 0); PG8_LDB(B1, 0, 1); PG8_SCHED; PG8_LDA(At, 0, 0); PG8_STAGE(PG8_SA(1, 1), a1 + hstep, voffA);
            PG8_WAIT_V(8); PG8_WAIT_L(0); PG8_BAR; PG8_MMA(0, 0, At, B0); PG8_MMA(0, 1, At, B1); PG8_BAR; PG8_SCHED;
            PG8_LDA(At, 0, 1); PG8_STAGE(PG8_SB(0, 0), b2, voffB); PG8_STAGE(PG8_SB(0, 1), b2 + hstep, voffB); PG8_STAGE(PG8_SA(0, 0), a2, voffA);
            PG8_WAIT_V(8); PG8_WAIT_L(0); PG8_BAR; PG8_MMA(1, 0, At, B0); PG8_MMA(1, 1, At, B1); PG8_BAR; PG8_SCHED;
            PG8_LDB(B0, 1, 0); PG8_LDB(B1, 1, 1); PG8_SCHED; PG8_LDA(At, 1, 0); PG8_STAGE(PG8_SA(0, 1), a2 + hstep, voffA);
            PG8_WAIT_V(8); PG8_WAIT_L(0); PG8_BAR; PG8_MMA(0, 0, At, B0); PG8_MMA(0, 1, At, B1); PG8_BAR; PG8_SCHED;
            PG8_LDA(At, 1, 1); PG8_STAGE(PG8_SB(1, 0), b3, voffB); PG8_STAGE(PG8_SB(1, 1), b3 + hstep, voffB); PG8_STAGE(PG8_SA(1, 0), a3, voffA);
            PG8_WAIT_V(8); PG8_WAIT_L(0); PG8_BAR; PG8_MMA(1, 0, At, B0); PG8_MMA(1, 1, At, B1); PG8_BAR; PG8_SCHED;
            } else {
            PG8_LDB(B0, 0, 0); PG8_SCHED; PG8_LDA(At, 0, 0); PG8_STAGE(PG8_SA(1, 1), a1 + hstep, voffA);
            PG8_WAIT_L(8); PG8_BAR; PG8_WAIT_L(0); PG8_MMA(0, 0, At, B0); PG8_BAR; PG8_SCHED;
            PG8_LDB(B1, 0, 1); PG8_STAGE(PG8_SB(0, 0), b2, voffB);
            PG8_BAR; PG8_WAIT_L(0); PG8_MMA(0, 1, At, B1); PG8_BAR;
            PG8_LDA(At, 0, 1); PG8_STAGE(PG8_SA(0, 0), a2, voffA);
            PG8_BAR; PG8_WAIT_L(0); PG8_MMA(1, 0, At, B0); PG8_BAR; PG8_SCHED;
            PG8_STAGE(PG8_SB(0, 1), b2 + hstep, voffB);
            PG8_WAIT_V(6); PG8_BAR; PG8_MMA(1, 1, At, B1); PG8_BAR;
            PG8_LDB(B0, 1, 0); PG8_SCHED; PG8_LDA(At, 1, 0); PG8_STAGE(PG8_SA(0, 1), a2 + hstep, voffA);
            PG8_WAIT_L(8); PG8_BAR; PG8_WAIT_L(0); PG8_MMA(0, 0, At, B0); PG8_BAR; PG8_SCHED;
            PG8_LDB(B1, 1, 1); PG8_STAGE(PG8_SB(1, 0), b3, voffB);
            PG8_BAR; PG8_WAIT_L(0); PG8_MMA(0, 1, At, B1); PG8_BAR;
            PG8_LDA(At, 1, 1); PG8_STAGE(PG8_SA(1, 0), a3, voffA);
            PG8_BAR; PG8_WAIT_L(0); PG8_MMA(1, 0, At, B0); PG8_BAR; PG8_SCHED;
            PG8_STAGE(PG8_SB(1, 1), b3 + hstep, voffB);
            PG8_WAIT_V(6); PG8_BAR; PG8_MMA(1, 1, At, B1); PG8_BAR;
            }
        }
        if constexpr (ALIGN_EPI) { if (wr == 0) PG8_BAR; }
        if constexpr (!Epi::AFTER_DRAIN) { E(acc, cur, wr, wc, fr, fq, lds + STAGE_BYTES + (ui & 1) * 4096); S.done(cur); }
        if (!has_next) break;
#pragma unroll
        for (int a = 0; a < 2; ++a)
#pragma unroll
            for (int b = 0; b < 2; ++b)
#pragma unroll
                for (int m = 0; m < 4; ++m)
#pragma unroll
                    for (int n = 0; n < 2; ++n) acc[a][b][m][n] = (f32x4){0.f, 0.f, 0.f, 0.f};
        cur = nxt; cA = nA; cB = nB; ++ui;
        if constexpr (ALIGN_EPI) { if (wr == 1) PG8_BAR; }
    }
    PG8_WAIT_V(0);
    if constexpr (!ALIGN_EPI) { if (wr == 0) PG8_BAR; }
    PG8_BAR;
    if constexpr (Epi::AFTER_DRAIN) { E.fused(acc, cur, wr, wc, fr, fq, lds, wid, lane); S.done(cur); }
#undef PG8_SA
#undef PG8_SB
#undef PG8_STAGE
#undef PG8_LDA
#undef PG8_LDB
#undef PG8_MMA
#undef PG8_WAIT_V
#undef PG8_WAIT_L
#undef PG8_BAR
#undef PG8_SCHED
}
}

#define GAS __attribute__((address_space(1)))
#define LAS __attribute__((address_space(3)))
typedef unsigned short bf16;
typedef float f32x2 __attribute__((ext_vector_type(2)));
typedef float f32x4 __attribute__((ext_vector_type(4)));
typedef float f32x16 __attribute__((ext_vector_type(16)));
typedef short bf16x8 __attribute__((ext_vector_type(8)));
typedef short s16x4 __attribute__((ext_vector_type(4)));
typedef unsigned u32x2 __attribute__((ext_vector_type(2)));
typedef unsigned u32x4 __attribute__((ext_vector_type(4)));

constexpr int DM = 2048, SEQ = 2048, MP = 8192, MROWS = 8200, MPAD = 8448;
constexpr int DFF = 5632, NFF2 = 11264, NIN = 16640, INCOLS = 16496;
constexpr int PAST = 16384, NPAGES = 128;
constexpr int CONVD = 6144;
constexpr float DN_ALPHA = 1.189207115002721f;
constexpr float QSCALE = 0.08838834764831845f * 1.4426950408889634f;
constexpr float LOG2E = 1.4426950408889634f;

constexpr size_t O_YP = 0, O_YS = 16777216, O_KP = 16793600, O_VP = 20987904, O_IKP = 25182208, O_SSMP = 25706496, O_CONVP = 26755072,
                 O_KS = 26828800, O_VS = 26832896, O_IKS = 26836992, O_SSMS = 26837504, O_CONVS = 28934656, O_END = 29082112;

constexpr size_t al256(size_t x) { return (x + 255) & ~(size_t)255; }
constexpr size_t WS_CTL = 0, CTL_BYTES = 1u << 20;
constexpr size_t WS_ROPEA = CTL_BYTES;
constexpr size_t WS_ROPEI = WS_ROPEA + al256(2049 * 16 * 8);
constexpr size_t WS_W1T = WS_ROPEI + al256(2049 * 8 * 8);
constexpr size_t WS_W1D = WS_W1T + (size_t)NFF2 * DM * 2;
constexpr size_t WS_WIN = WS_W1D + (size_t)DM * DFF * 2;
constexpr size_t WS_WO = WS_WIN + (size_t)NIN * DM * 2;
constexpr size_t WS_W2T = WS_WO + (size_t)DM * DM * 2;
constexpr size_t WS_W2D = WS_W2T + (size_t)NFF2 * DM * 2;
constexpr size_t WS_XB = WS_W2D + (size_t)DM * DFF * 2;
constexpr size_t WS_H = WS_XB + (size_t)MPAD * DM * 2;
constexpr size_t WS_PRE = WS_H + (size_t)MPAD * DFF * 2;
constexpr size_t WS_X1 = WS_PRE + (size_t)MPAD * DM * 4;
constexpr size_t WS_X1B = WS_X1 + (size_t)MPAD * DM * 4;
constexpr size_t WS_Q = WS_X1B + (size_t)MPAD * DM * 2;
constexpr size_t WS_KB = WS_Q + (size_t)MPAD * DM * 2;
constexpr size_t WS_VB = WS_KB + (size_t)MPAD * 512 * 2;
constexpr size_t WS_QI = WS_VB + (size_t)MPAD * 512 * 2;
constexpr size_t WS_KI = WS_QI + (size_t)MPAD * 1024 * 2;
constexpr size_t WS_QIS = WS_KI + (size_t)MPAD * 64 * 2;
constexpr size_t WS_WIDX = WS_QIS + 8 * 1024 * 4;
constexpr size_t WS_GDEC = WS_WIDX + (size_t)MPAD * 16 * 4;
constexpr size_t WS_BETA = WS_GDEC + (size_t)MPAD * 16 * 4;
constexpr size_t WS_RAW = WS_BETA + (size_t)MPAD * 16 * 4;
constexpr size_t WS_ZS = WS_RAW + (size_t)MPAD * CONVD * 2;
constexpr size_t WS_GA = WS_ZS + (size_t)MPAD * DM * 2;
constexpr size_t WS_GB = WS_GA + (size_t)MPAD * DM * 2;
constexpr size_t WS_QH = WS_GB + (size_t)MPAD * DM * 2;
constexpr size_t WS_KH = WS_QH + (size_t)MPAD * DM * 2;
constexpr size_t WS_VH = WS_KH + (size_t)MPAD * DM * 2;
constexpr size_t WS_SC = WS_VH + (size_t)MPAD * DM * 2;
constexpr size_t WS_MASK = WS_SC + (size_t)MP * SEQ * 4;
constexpr size_t WS_SCS = WS_MASK + (size_t)MP * 64 * 4;
constexpr size_t WS_SELS = WS_SCS + 8 * 16640 * 4;
constexpr size_t WS_OA = WS_SELS + 32 * 256 * 4;
constexpr size_t WS_OB = WS_OA + (size_t)MPAD * DM * 2;
constexpr size_t WS_MRG = WS_OB + (size_t)MPAD * DM * 4;
constexpr size_t WS_END = WS_MRG + (size_t)MPAD * DM * 2;

constexpr size_t CW_ST1 = 0x10000, CW_ST2 = 0x21000;
constexpr size_t CW_CSIN = 0x32000, CW_BBIN = 0x43000;
constexpr size_t CW_CSGU = 0x54000, CW_BBGU = 0x60000;
constexpr size_t CW_ST3 = 0x70000, CW_PCNT = 0x81000;
constexpr size_t CW_GDNA = 0x6C000;
constexpr int LDS_BYTES = 163840;
constexpr int LDS_MISC = 159744;

struct P {
    const float *x_prompt, *x_sample, *cache_k, *cache_v, *cache_ik, *state_ssm, *state_conv; const int* page_table;
    const float *w1g, *w1u, *w1d, *ln1g, *ln1b, *win, *convw, *alog, *dtb, *gng, *wo, *ln2g, *ln2b, *w2g, *w2u, *w2d, *ln3g, *ln3b;
    float* out; unsigned char* ws;
};

typedef __bf16 bf16x2_t __attribute__((ext_vector_type(2)));
__device__ __forceinline__ unsigned pkbf(float lo, float hi) { const f32x2 v = {lo, hi}; const bf16x2_t b = __builtin_convertvector(v, bf16x2_t); return __builtin_bit_cast(unsigned, b); }
__device__ __forceinline__ float bf2f(unsigned short b) { return __builtin_bit_cast(float, (unsigned)b << 16); }
__device__ __forceinline__ float bflo(unsigned w) { return __builtin_bit_cast(float, w << 16); }
__device__ __forceinline__ float bfhi(unsigned w) { return __builtin_bit_cast(float, w & 0xffff0000u); }
__device__ __forceinline__ u32x2 pk4(f32x4 v) { u32x2 r; r.x = pkbf(v[0], v[1]); r.y = pkbf(v[2], v[3]); return r; }
__device__ __forceinline__ f32x4 unpk4(u32x2 w) { return (f32x4){bflo(w.x), bfhi(w.x), bflo(w.y), bfhi(w.y)}; }
__device__ __forceinline__ float fexp2(float x) { return __builtin_amdgcn_exp2f(x); }
__device__ __forceinline__ float frcp(float x) { return __builtin_amdgcn_rcpf(x); }
__device__ __forceinline__ float sigmoidf_(float x) { return frcp(1.f + fexp2(-x * LOG2E)); }
__device__ __forceinline__ float siluf_(float x) { return x * sigmoidf_(x); }
__device__ __forceinline__ f32x4 silu4(f32x4 v) { return (f32x4){siluf_(v[0]), siluf_(v[1]), siluf_(v[2]), siluf_(v[3])}; }
__device__ __forceinline__ f32x4 sigm4(f32x4 v) { return (f32x4){sigmoidf_(v[0]), sigmoidf_(v[1]), sigmoidf_(v[2]), sigmoidf_(v[3])}; }
__device__ __forceinline__ float fmax_fast(float a, float b) { return __builtin_amdgcn_fmed3f(a, b, __builtin_inff()); }
__device__ __forceinline__ float relu_fast(float a) { return __builtin_amdgcn_fmed3f(a, 0.f, __builtin_inff()); }
#define LDS_WAIT() asm volatile("s_waitcnt lgkmcnt(0)" ::: "memory")
__device__ __forceinline__ void lds_barrier() { asm volatile("s_waitcnt lgkmcnt(0)" ::: "memory"); __builtin_amdgcn_s_barrier(); asm volatile("" ::: "memory"); }
#define VM_WAIT() asm volatile("s_waitcnt vmcnt(0)" ::: "memory")

__device__ __forceinline__ void tr_item(const float* src, int srcN, int c0, int c1, bool v0, bool v1, int K, bf16* dst, int dst_r0, int k0, LAS float* scr, int lane,
                                        const float* lng, const float* lnb, float* cs, float* bb) {
    const int c = lane & 31; const bool ok = (c < 16) ? v0 : v1; const int sc = (c < 16) ? (c0 + c) : (c1 + c - 16);
    float bsum = 0.f;
#pragma unroll 8
    for (int i = 0; i < 32; ++i) { const int kk = 2 * i + (lane >> 5); float w = ok ? src[(size_t)(k0 + kk) * srcN + sc] : 0.f;
        if (lng) { bsum += lnb[k0 + kk] * w; w *= lng[k0 + kk]; }
        scr[kk * 33 + c] = w; }
    if (lng) { bsum += __shfl_xor(bsum, 32); if (lane < 32) atomicAdd(bb + dst_r0 + c, bsum); }
    LDS_WAIT(); asm volatile("" ::: "memory");
    const int c8 = lane & 7;
#pragma unroll
    for (int j = 0; j < 4; ++j) { const int n = (lane >> 3) + 8 * j; const LAS float* s = scr + (8 * c8) * 33 + n;
        u32x4 o; o.x = pkbf(s[0 * 33], s[1 * 33]); o.y = pkbf(s[2 * 33], s[3 * 33]); o.z = pkbf(s[4 * 33], s[5 * 33]); o.w = pkbf(s[6 * 33], s[7 * 33]);
        *(u32x4*)(dst + (size_t)(dst_r0 + n) * K + k0 + 8 * c8) = o;
        if (lng) { float q = ((bflo(o.x) + bfhi(o.x)) + (bflo(o.y) + bfhi(o.y))) + ((bflo(o.z) + bfhi(o.z)) + (bflo(o.w) + bfhi(o.w)));
            q += __shfl_xor(q, 1); q += __shfl_xor(q, 2); q += __shfl_xor(q, 4); if (c8 == 0) atomicAdd(cs + dst_r0 + n, q); } }
    LDS_WAIT(); asm volatile("" ::: "memory");
}

__device__ __forceinline__ void tr_item64(const float* src, int srcN, int sc0, int K, bf16* dst, int dst_r0, int k0, int lane,
                                          const float* lng, const float* lnb, float* cs, float* bb, int permmask = 0) {
    const int kq = lane >> 4, c = lane & 15;
    const int rb4 = ((permmask >> (c >> 3)) & 1) ? 32 * (c >> 3) + 16 * (c & 1) + 4 * ((c & 7) >> 1) : 4 * c;
    const float* sp = src + (size_t)(k0 + 16 * kq) * srcN + sc0 + 4 * c;
    f32x4 v[16];
#pragma unroll
    for (int i = 0; i < 16; ++i) v[i] = __builtin_nontemporal_load((const f32x4*)(sp + (size_t)i * srcN));
    if (lng) {
        f32x4 bs = {0.f, 0.f, 0.f, 0.f};
#pragma unroll
        for (int q = 0; q < 4; ++q) { const f32x4 gq = *(const f32x4*)(lng + k0 + 16 * kq + 4 * q), bq = *(const f32x4*)(lnb + k0 + 16 * kq + 4 * q);
#pragma unroll
            for (int e = 0; e < 4; ++e) { bs += v[4 * q + e] * bq[e]; v[4 * q + e] = v[4 * q + e] * gq[e]; } }
#pragma unroll
        for (int j = 0; j < 4; ++j) { float t = bs[j]; t += __shfl_xor(t, 16); t += __shfl_xor(t, 32); if (kq == 0) atomicAdd(bb + dst_r0 + rb4 + j, t); }
    }
    bf16* dp = dst + (size_t)(dst_r0 + rb4) * K + k0 + 16 * kq;
#pragma unroll
    for (int j = 0; j < 4; ++j) {
        u32x4 w0, w1;
        w0.x = pkbf(v[0][j], v[1][j]); w0.y = pkbf(v[2][j], v[3][j]); w0.z = pkbf(v[4][j], v[5][j]); w0.w = pkbf(v[6][j], v[7][j]);
        w1.x = pkbf(v[8][j], v[9][j]); w1.y = pkbf(v[10][j], v[11][j]); w1.z = pkbf(v[12][j], v[13][j]); w1.w = pkbf(v[14][j], v[15][j]);
        *(u32x4*)(dp + (size_t)j * K) = w0; *(u32x4*)(dp + (size_t)j * K + 8) = w1;
        if (lng) { float q = (((bflo(w0.x) + bfhi(w0.x)) + (bflo(w0.y) + bfhi(w0.y))) + ((bflo(w0.z) + bfhi(w0.z)) + (bflo(w0.w) + bfhi(w0.w))))
                           + (((bflo(w1.x) + bfhi(w1.x)) + (bflo(w1.y) + bfhi(w1.y))) + ((bflo(w1.z) + bfhi(w1.z)) + (bflo(w1.w) + bfhi(w1.w))));
            q += __shfl_xor(q, 16); q += __shfl_xor(q, 32); if (kq == 0) atomicAdd(cs + dst_r0 + rb4 + j, q); }
    }
}

__device__ __forceinline__ void sincos_d(float ang, float& s_out, float& c_out) {
    const double x = (double)ang;
    const double n = __builtin_rint(x * 0.63661977236758134308);
    double r = x - n * 1.57079632673412561417e+00; r = r - n * 6.07710050650619224932e-11;
    const double r2 = r * r;
    double sp = -7.6471637318198164759e-13; sp = sp * r2 + 1.6059043836821614599e-10; sp = sp * r2 - 2.5052108385441718775e-08; sp = sp * r2 + 2.7557319223985890653e-06;
    sp = sp * r2 - 1.9841269841269841270e-04; sp = sp * r2 + 8.3333333333333333333e-03; sp = sp * r2 - 1.6666666666666666667e-01; const double sn = r + r * r2 * sp;
    double cp = 4.7794773323873852974e-14; cp = cp * r2 - 1.1470745597729724714e-11; cp = cp * r2 + 2.0876756987868098979e-09; cp = cp * r2 - 2.7557319223985890653e-07;
    cp = cp * r2 + 2.4801587301587301587e-05; cp = cp * r2 - 1.3888888888888888889e-03; cp = cp * r2 + 4.1666666666666666667e-02; cp = cp * r2 - 0.5; const double cs = 1.0 + r2 * cp;
    const int q = ((int)n) & 3;
    const double s = (q == 0) ? sn : (q == 1) ? cs : (q == 2) ? -sn : -cs;
    const double c = (q == 0) ? cs : (q == 1) ? -sn : (q == 2) ? -cs : sn;
    s_out = (float)s; c_out = (float)c;
}

__device__ __forceinline__ void convert_ffn2(const P& p, int gwi, int ngw, int lane) {
    bf16* W2T = (bf16*)(p.ws + WS_W2T); bf16* W2D = (bf16*)(p.ws + WS_W2D);
    constexpr int I_GU = 32 * 176, I_D = 88 * 32, I_O = 32 * 32;
    for (int it = gwi; it < I_GU + I_D + I_O; it += ngw) {
        if (it >= I_GU + I_D) { const int r = it - I_GU - I_D, kb = r / 32, nb = r % 32;
            tr_item64(p.wo, DM, nb * 64, DM, (bf16*)(p.ws + WS_WO), nb * 64, kb * 64, lane, nullptr, nullptr, nullptr, nullptr, 3); continue; }
        if (it < I_GU) { const int kb = it / 176, nb = it % 176, tile = nb >> 2, blk = nb & 3;
            tr_item64(blk < 2 ? p.w2g : p.w2u, DFF, tile * 128 + (blk & 1) * 64, DM, W2T, nb * 64, kb * 64, lane, p.ln2g, p.ln2b, (float*)(p.ws + CW_CSGU), (float*)(p.ws + CW_BBGU)); }
        else { const int r = it - I_GU, kb = r / 32, nb = r % 32; tr_item64(p.w2d, DM, nb * 64, DFF, W2D, nb * 64, kb * 64, lane, nullptr, nullptr, nullptr, nullptr); }
    }
}

__device__ __forceinline__ void p0_prologue(const P& p, LAS unsigned char* lds) {
    const int tid = otid(), lane = tid & 63, wid = tid >> 6;
    const int gw = blockIdx.x * 8 + wid, NGW = gridDim.x * 8;
    LAS float* scr = (LAS float*)(lds + wid * 8448);
    bf16* W1T = (bf16*)(p.ws + WS_W1T); bf16* W1D = (bf16*)(p.ws + WS_W1D); bf16* WIN = (bf16*)(p.ws + WS_WIN); bf16* WO = (bf16*)(p.ws + WS_WO);
    constexpr int I_GU = 32 * 176, I_D = 88 * 32, I_O = 0  , I_IN = 32 * 256, I_SM = 32 * 8;
    constexpr int NITEMS = I_GU + I_D + I_O + I_IN + I_SM;
    for (int it = gw; it < NITEMS; it += NGW) {
        int r = it;
        if (r < I_GU) {
            const int kb = r / 176, nb = r % 176, tile = nb >> 2, blk = nb & 3;
            tr_item64(blk < 2 ? p.w1g : p.w1u, DFF, tile * 128 + (blk & 1) * 64, DM, W1T, nb * 64, kb * 64, lane, nullptr, nullptr, nullptr, nullptr); continue; }
        r -= I_GU;
        if (r < I_D) { const int kb = r / 32, nb = r % 32;
            tr_item64(p.w1d, DM, nb * 64, DFF, W1D, nb * 64, kb * 64, lane, nullptr, nullptr, nullptr, nullptr, 3); continue; }
        r -= I_D;
        if (r < I_O) { const int kb = r / 32, nb = r % 32; tr_item64(p.wo, DM, nb * 64, DM, WO, nb * 64, kb * 64, lane, nullptr, nullptr, nullptr, nullptr, 3); continue; }
        r -= I_O;
        if (r < I_IN) { const int kb = r / 256, nb = r % 256;
            const int sc = nb < 64 ? nb * 64 : nb < 160 ? 4176 + (nb - 64) * 64 : 10352 + (nb - 160) * 64;
            const int pn_ = nb >> 2, g8 = (nb & 3) * 2; int pm_ = 0;
#pragma unroll
            for (int hh = 0; hh < 2; ++hh) { const int wc_ = (g8 + hh) & 3; const bool nat = (pn_ < 10 && wc_ == 0) || (pn_ >= 12 && pn_ < 16 && (wc_ & 1) == 0); pm_ |= nat ? 0 : (1 << hh); }
            tr_item64(p.win, INCOLS, sc, DM, WIN, nb * 64, kb * 64, lane, p.ln1g, p.ln1b, (float*)(p.ws + CW_CSIN), (float*)(p.ws + CW_BBIN), pm_); continue; }
        r -= I_IN;
        {   const int kb = r / 8, nb = 512 + (r % 8); int c0, c1; bool v0 = true, v1 = true;
            if (nb < 514) { c0 = 4096 + (nb - 512) * 32; c1 = c0 + 16; }
            else if (nb == 514) { c0 = 4160; c1 = 10320; }
            else if (nb == 515) { c0 = 10336; c1 = 0; v1 = false; }
            else { c0 = 0; c1 = 0; v0 = false; v1 = false; }
            tr_item(p.win, INCOLS, c0, c1, v0, v1, DM, WIN, nb * 32, kb * 64, scr, lane, p.ln1g, p.ln1b, (float*)(p.ws + CW_CSIN), (float*)(p.ws + CW_BBIN)); }
    }
    bf16* XB = (bf16*)(p.ws + WS_XB);
    for (int row = gw; row < MROWS; row += NGW) {
        const float* xr = row < MP ? p.x_prompt + (size_t)row * DM : p.x_sample + (size_t)(row - MP) * DM;
#pragma unroll
        for (int j = 0; j < 8; ++j) { const f32x4 v = *(const f32x4*)(xr + j * 256 + lane * 4); *(u32x2*)(XB + (size_t)row * DM + j * 256 + lane * 4) = pk4(v); }
    }
    {   const float invA[16] = {1.000000000e+00f, 4.403665960e-01f, 1.939227432e-01f, 8.539710194e-02f, 3.760603070e-02f, 1.656043902e-02f, 7.292664610e-03f, 3.211445874e-03f,
                                1.414213562e-03f, 6.227723788e-04f, 2.742481884e-04f, 1.207697351e-04f, 5.318296098e-05f, 2.341999971e-05f, 1.031338616e-05f, 4.541670478e-06f};
        f32x2* RA = (f32x2*)(p.ws + WS_ROPEA); f32x2* RI = (f32x2*)(p.ws + WS_ROPEI);
        const int gt = blockIdx.x * 512 + tid, NT = gridDim.x * 512;
        for (int e = gt; e < 2049 * 16; e += NT) { const int pi = e >> 4, i = e & 15; const float pos = pi < 2048 ? (float)pi : 16384.f;
            float iv = invA[0];
#pragma unroll
            for (int k = 1; k < 16; ++k) iv = (i == k) ? invA[k] : iv;
            const float ang = pos * iv; float s, c; sincos_d(ang, s, c); RA[e] = (f32x2){c, s};
            if ((i & 1) == 0) { RI[pi * 8 + (i >> 1)] = (f32x2){c, s}; } }
        if (gt < 16) { float* ga = (float*)(p.ws + CW_GDNA); ga[gt] = -__expf(p.alog[gt]); ga[16 + gt] = p.dtb[gt]; }
        for (int e = gt; e < 8 * 2 * CONVD; e += NT) { const int d = e / (2 * CONVD), rem = e % (2 * CONVD);
            p.out[O_CONVS + (size_t)d * 3 * CONVD + rem] = p.state_conv[(size_t)d * 3 * CONVD + CONVD + rem]; }
    }
}
#define XB_TMO      128
#define XB_XCNT(j)  (256  + 64 * (j))
#define XB_XSUB(j)  (1280 + 64 * (j))
#define XB_XGEN(j)  (2304 + 64 * (j))
#define XB_TOP      3328
#define XB_TOPGEN   3392
#define XCD_BAR_WORDS 3456
#define XB_SPIN_CAP (1u << 18)

__device__ __forceinline__ unsigned xb_ld(unsigned* p)              { return __hip_atomic_load(p, __ATOMIC_RELAXED, __HIP_MEMORY_SCOPE_AGENT); }
__device__ __forceinline__ unsigned xb_add(unsigned* p, unsigned v) { return __hip_atomic_fetch_add(p, v, __ATOMIC_RELAXED, __HIP_MEMORY_SCOPE_AGENT); }
__device__ __forceinline__ unsigned xb_xcc_id() { return (unsigned)__builtin_amdgcn_s_getreg((3 << 11) | 20) & 0xFu; }
#define XB_SPIN(cond, bar) do { unsigned _sp = 0; while (cond) { __builtin_amdgcn_s_sleep(1); \
    if ((++_sp & 255u) == 0u) { if (xb_ld(&(bar)[XB_TMO])) break; if (_sp > XB_SPIN_CAP) { atomicAdd(&(bar)[XB_TMO], 1u); break; } } } } while (0)

struct XcdBarrier {
    unsigned* bar; unsigned x;
    volatile LAS unsigned* st;
};

__device__ __forceinline__ XcdBarrier xcd_barrier_post(unsigned* bar, volatile LAS unsigned* st) {
    XcdBarrier b; b.bar = bar; b.x = xb_xcc_id(); b.st = st;
    if (threadIdx.x == 0) (void)xb_add(&bar[XB_XCNT(b.x)], 1u);
    return b;
}
__device__ __forceinline__ void xcd_barrier_complete(unsigned* bar, unsigned x, unsigned& nloc, unsigned& nx) {
    const unsigned G = gridDim.x * gridDim.y * gridDim.z;
    unsigned sum, cnt, mine, sp = 0u;
    for (;;) {
        sum = 0u; cnt = 0u; mine = 0u;
#pragma unroll
        for (unsigned j = 0; j < 16; ++j) { const unsigned c = xb_ld(&bar[XB_XCNT(j)]); sum += c; cnt += (c > 0u) ? 1u : 0u; mine = (j == x) ? c : mine; }
        if (sum == G) break;
        __builtin_amdgcn_s_sleep(1);
        if ((++sp & 255u) == 0u) { if (xb_ld(&bar[XB_TMO])) break; if (sp > XB_SPIN_CAP) { atomicAdd(&bar[XB_TMO], 1u); break; } }
    }
    nloc = mine > 0u ? mine : 1u; nx = cnt > 0u ? cnt : 1u;
}

__device__ __forceinline__ void xcd_barrier(const XcdBarrier& b) {
    asm volatile("s_waitcnt vmcnt(0)" ::: "memory");
    __syncthreads();
    if (threadIdx.x == 0) {
        unsigned* bar = b.bar;
        __builtin_amdgcn_s_waitcnt(0);
        unsigned nloc = b.st[0], nx = b.st[1];
        if (nloc == 0u) { xcd_barrier_complete(bar, b.x, nloc, nx); b.st[0] = nloc; b.st[1] = nx; }
        const unsigned old = xb_add(&bar[XB_XSUB(b.x)], 1u);
        const unsigned gen = old / nloc;
        if (old + 1u == (gen + 1u) * nloc) {
            __builtin_amdgcn_fence(__ATOMIC_RELEASE, "agent");
            asm volatile("s_waitcnt vmcnt(0)" ::: "memory");
            const unsigned og = xb_add(&bar[XB_TOP], 1u);
            const unsigned tg = og / nx;
            if (og + 1u == (tg + 1u) * nx) xb_add(&bar[XB_TOPGEN], 1u);
            else XB_SPIN(xb_ld(&bar[XB_TOPGEN]) == tg, bar);
            __builtin_amdgcn_fence(__ATOMIC_ACQUIRE, "agent");
            xb_add(&bar[XB_XGEN(b.x)], 1u);
            asm volatile("s_waitcnt vmcnt(0)" ::: "memory");
        } else {
            XB_SPIN(xb_ld(&bar[XB_XGEN(b.x)]) == gen, bar);
            __builtin_amdgcn_fence(__ATOMIC_ACQUIRE, "agent");
            asm volatile("s_waitcnt vmcnt(0)" ::: "memory");
        }
    }
    __syncthreads();
}


__device__ __forceinline__ f32x2 ln_stats(f32x2 s) {
    const float mean = s.x * (1.f / DM), var = fmaxf(s.y * (1.f / DM) - mean * mean, 0.f), rstd = __builtin_amdgcn_rsqf(var + 1e-5f);
    return (f32x2){rstd, rstd * mean};
}
__device__ __forceinline__ f32x2 ln_row(const float* st, int row) {
    const f32x2 s = *(const f32x2*)(st + (size_t)row * 2);
    const float mean = s.x * (1.f / DM), var = fmaxf(s.y * (1.f / DM) - mean * mean, 0.f), rstd = 1.0f / sqrtf(var + 1e-5f);
    return (f32x2){rstd, rstd * mean};
}
template <bool LNF> struct EpiSwiglu {
    static constexpr bool PERM = true, AFTER_DRAIN = false, PF = LNF;
    bf16* H; const float *st, *cs, *bb;
    __device__ __forceinline__ const float* pf_stats() const { return st; }
    __device__ __forceinline__ const float* pf_vec0() const { return cs; }
    __device__ __forceinline__ const float* pf_vec1() const { return bb; }
    __device__ __forceinline__ void operator()(const f32x4 (&acc)[2][2][4][2], const pg8::Unit& u, int wr, int wc, int fr, int fq, const LAS unsigned char* ops) const {
        const int row0 = u.pm * 256 + wr * 64 + fr, col0 = u.pn * 128 + wc * 32 + 8 * fq;
        f32x4 csv[2][2], bbv[2][2];
        if constexpr (LNF) {
#pragma unroll
            for (int bj = 0; bj < 2; ++bj)
#pragma unroll
                for (int n = 0; n < 2; ++n) { const int nn = bj * 128 + wc * 32 + 8 * fq + 4 * n; csv[bj][n] = *(const LAS f32x4*)(ops + 2048 + nn * 4); bbv[bj][n] = *(const LAS f32x4*)(ops + 3072 + nn * 4); }
        }
        f32x2 rsv[2][4];
        if constexpr (LNF) {
#pragma unroll
            for (int ai = 0; ai < 2; ++ai)
#pragma unroll
                for (int m = 0; m < 4; ++m) rsv[ai][m] = *(const LAS f32x2*)(ops + (wr * 64 + fr + ai * 128 + m * 16) * 8);
        }
#pragma unroll
        for (int ai = 0; ai < 2; ++ai)
#pragma unroll
            for (int m = 0; m < 4; ++m) {
                const int row = row0 + ai * 128 + m * 16;
                f32x4 g0 = acc[ai][0][m][0], g1 = acc[ai][0][m][1], u0 = acc[ai][1][m][0], u1 = acc[ai][1][m][1];
                if constexpr (LNF) { const f32x2 rs = ln_stats(rsv[ai][m]);
                    g0 = g0 * rs.x - csv[0][0] * rs.y + bbv[0][0]; g1 = g1 * rs.x - csv[0][1] * rs.y + bbv[0][1];
                    u0 = u0 * rs.x - csv[1][0] * rs.y + bbv[1][0]; u1 = u1 * rs.x - csv[1][1] * rs.y + bbv[1][1]; }
                const f32x4 h0 = silu4(g0) * u0, h1 = silu4(g1) * u1;
                u32x4 w; w.x = pkbf(h0[0], h0[1]); w.y = pkbf(h0[2], h0[3]); w.z = pkbf(h1[0], h1[1]); w.w = pkbf(h1[2], h1[3]);
                *(u32x4*)(H + (size_t)row * DFF + col0) = w;
            }
    }
};
template <int MODE> struct EpiResid {
    static constexpr bool PERM = false, AFTER_DRAIN = false, RLN = MODE != 0, OUTB = MODE != 2, PF = RLN, OUTF = MODE == 2, P8 = MODE != 2;
    static constexpr int CQ = P8 ? 8 : 4, CN = P8 ? 4 : 16;
    unsigned char* ws; const float* xin; const float *lg, *lb; float scale;
    __device__ __forceinline__ const float* pf_stats() const { return (const float*)(ws + (MODE == 1 ? CW_ST1 : CW_ST2)); }
    __device__ __forceinline__ const float* pf_vec0() const { return lg; }
    __device__ __forceinline__ const float* pf_vec1() const { return lb; }
    __device__ __forceinline__ void operator()(const f32x4 (&acc)[2][2][4][2], const pg8::Unit& u, int wr, int wc, int fr, int fq, const LAS unsigned char* ops) const {
        const int row0 = u.pm * 256 + wr * 64 + fr, col0 = u.pn * 256 + wc * 32 + CQ * fq;
        float* const out = (float*)(ws + WS_PRE); bf16* const outb = (bf16*)(ws + WS_X1B);
        float* const stn = (float*)(ws + (MODE == 0 ? CW_ST1 : CW_ST2));
        const LAS unsigned char* const opv = ops + 2048 + (wc * 32 + CQ * fq) * 4;
        const LAS unsigned char* const opr = ops + (wr * 64 + fr) * 8;
        u32x4 xa[2][2], xb[2][2];
#define ER_LOAD(X, R) { _Pragma("unroll") for (int bj = 0; bj < 2; ++bj) _Pragma("unroll") for (int n = 0; n < 2; ++n) { \
            const size_t i_ = (size_t)(row0 + ((R) >> 2) * 128 + ((R) & 3) * 16) * DM + col0 + bj * 128 + n * CN; \
            if constexpr (RLN && P8) { if (n == 0) { const u32x4 t_ = *(const u32x4*)(outb + i_); X[bj][0].x = t_.x; X[bj][0].y = t_.y; X[bj][1].x = t_.z; X[bj][1].y = t_.w; } } \
            else if constexpr (RLN) { const u32x2 t_ = *(const u32x2*)(outb + i_); X[bj][n].x = t_.x; X[bj][n].y = t_.y; } else X[bj][n] = *(const u32x4*)(xin + i_); } }
#define ER_DO(X, R) { const int ai = (R) >> 2, m = (R) & 3; const int row = row0 + ai * 128 + m * 16; const size_t ro = (size_t)row * DM + col0; \
            f32x2 rs = {0.f, 0.f}; if constexpr (RLN) rs = ln_stats(*(const LAS f32x2*)(opr + (ai * 128 + m * 16) * 8)); \
            float s1 = 0.f, s2 = 0.f; u32x2 pk0_ = {0u, 0u}; \
            _Pragma("unroll") for (int bj = 0; bj < 2; ++bj) _Pragma("unroll") for (int n = 0; n < 2; ++n) { f32x4 x; \
                if constexpr (RLN) x = (unpk4((u32x2){X[bj][n].x, X[bj][n].y}) * rs.x - rs.y) * *(const LAS f32x4*)(opv + (bj * 128 + n * CN) * 4) + *(const LAS f32x4*)(opv + 1024 + (bj * 128 + n * CN) * 4); \
                else x = __builtin_bit_cast(f32x4, X[bj][n]); \
                const f32x4 o = x * DN_ALPHA + acc[ai][bj][m][n] * scale; \
                if constexpr (OUTF) *(f32x4*)(out + ro + bj * 128 + n * CN) = o; \
                if constexpr (OUTB) { const u32x2 pk_ = pk4(o); if (n == 0) { pk0_ = pk_; } else { *(u32x4*)(outb + ro + bj * 128) = (u32x4){pk0_.x, pk0_.y, pk_.x, pk_.y}; } \
                    s1 += (o[0] + o[1]) + (o[2] + o[3]); s2 += (o[0] * o[0] + o[1] * o[1]) + (o[2] * o[2] + o[3] * o[3]); } } \
            if constexpr (OUTB) { s1 += __shfl_xor(s1, 16); s1 += __shfl_xor(s1, 32); s2 += __shfl_xor(s2, 16); s2 += __shfl_xor(s2, 32); \
                if (fq == 0) { atomicAdd(stn + (size_t)row * 2, s1); atomicAdd(stn + (size_t)row * 2 + 1, s2); } } }
        ER_LOAD(xa, 0)
#pragma unroll
        for (int r = 0; r < 8; r += 2) {
            ER_LOAD(xb, r + 1)
            __builtin_amdgcn_sched_barrier(0);
            ER_DO(xa, r)
            __builtin_amdgcn_sched_barrier(0);
            if (r + 2 < 8) ER_LOAD(xa, r + 2)
            __builtin_amdgcn_sched_barrier(0);
            ER_DO(xb, r + 1)
            __builtin_amdgcn_sched_barrier(0);
        }
#undef ER_DO
#undef ER_LOAD
    }
};
struct EpiLn3 {
    static constexpr bool PERM = false, AFTER_DRAIN = false, PF = true;
    unsigned char* ws; const float *lg, *lb, *g3, *b3; float* yout;
    __device__ __forceinline__ const float* pf_stats() const { return (const float*)(ws + CW_ST2); }
    __device__ __forceinline__ const float* pf_vec0() const { return lg; }
    __device__ __forceinline__ const float* pf_vec1() const { return lb; }
    __device__ __forceinline__ void operator()(f32x4 (&acc)[2][2][4][2], const pg8::Unit& u, int wr, int wc, int fr, int fq, const LAS unsigned char* ops) const {
        const int row0 = u.pm * 256 + wr * 64 + fr, col0 = u.pn * 256 + wc * 32 + 4 * fq;
        const bf16* const resb = (const bf16*)(ws + WS_X1B);
        float* const stn = (float*)(ws + CW_ST3);
        {
            const LAS unsigned char* const opv = ops + 2048 + (wc * 32 + 4 * fq) * 4;
            const LAS unsigned char* const opr = ops + (wr * 64 + fr) * 8;
            u32x2 xa[2][2], xb[2][2];
#define L3_LOAD(X, R) { _Pragma("unroll") for (int bj = 0; bj < 2; ++bj) _Pragma("unroll") for (int n = 0; n < 2; ++n) \
                X[bj][n] = *(const u32x2*)(resb + (size_t)(row0 + ((R) >> 2) * 128 + ((R) & 3) * 16) * DM + col0 + bj * 128 + n * 16); }
#define L3_DO(X, R) { const int ai = (R) >> 2, m = (R) & 3; const int row = row0 + ai * 128 + m * 16; \
                const f32x2 rs = ln_stats(*(const LAS f32x2*)(opr + (ai * 128 + m * 16) * 8)); \
                float s1 = 0.f, s2 = 0.f; \
                _Pragma("unroll") for (int bj = 0; bj < 2; ++bj) _Pragma("unroll") for (int n = 0; n < 2; ++n) { \
                    const f32x4 x = (unpk4(X[bj][n]) * rs.x - rs.y) * *(const LAS f32x4*)(opv + (bj * 128 + n * 16) * 4) + *(const LAS f32x4*)(opv + 1024 + (bj * 128 + n * 16) * 4); \
                    const f32x4 o = x * DN_ALPHA + acc[ai][bj][m][n] * 0.5f; \
                    acc[ai][bj][m][n] = o; \
                    s1 += (o[0] + o[1]) + (o[2] + o[3]); s2 += (o[0] * o[0] + o[1] * o[1]) + (o[2] * o[2] + o[3] * o[3]); } \
                s1 += __shfl_xor(s1, 16); s1 += __shfl_xor(s1, 32); s2 += __shfl_xor(s2, 16); s2 += __shfl_xor(s2, 32); \
                if (fq == 0) { atomicAdd(stn + (size_t)row * 2, s1); atomicAdd(stn + (size_t)row * 2 + 1, s2); } }
            L3_LOAD(xa, 0)
#pragma unroll
            for (int r = 0; r < 8; r += 2) {
                L3_LOAD(xb, r + 1)
                __builtin_amdgcn_sched_barrier(0);
                L3_DO(xa, r)
                __builtin_amdgcn_sched_barrier(0);
                if (r + 2 < 8) L3_LOAD(xa, r + 2)
                __builtin_amdgcn_sched_barrier(0);
                L3_DO(xb, r + 1)
                __builtin_amdgcn_sched_barrier(0);
            }
#undef L3_DO
#undef L3_LOAD
        }
        asm volatile("s_waitcnt vmcnt(0)" ::: "memory");
        __syncthreads();
        if (threadIdx.x == 0) {
            unsigned* bar = (unsigned*)(ws + WS_CTL); unsigned* pc = (unsigned*)(ws + CW_PCNT) + u.pm * 16;
            (void)xb_add(pc, 1u);
            XB_SPIN(xb_ld(pc) < 8u, bar);
        }
        __syncthreads();
        f32x4 gv[2][2], bv[2][2];
#pragma unroll
        for (int bj = 0; bj < 2; ++bj)
#pragma unroll
            for (int n = 0; n < 2; ++n) { gv[bj][n] = *(const f32x4*)(g3 + col0 + bj * 128 + n * 16); bv[bj][n] = *(const f32x4*)(b3 + col0 + bj * 128 + n * 16); }
#pragma unroll
        for (int ai = 0; ai < 2; ++ai) {
            f32x2 rsv[4];
#pragma unroll
            for (int m = 0; m < 4; ++m) { const float* sp = stn + (size_t)(row0 + ai * 128 + m * 16) * 2;
                rsv[m] = (f32x2){__hip_atomic_load(sp, __ATOMIC_RELAXED, __HIP_MEMORY_SCOPE_AGENT), __hip_atomic_load(sp + 1, __ATOMIC_RELAXED, __HIP_MEMORY_SCOPE_AGENT)}; }
#pragma unroll
            for (int m = 0; m < 4; ++m) {
                const f32x2 rs = ln_stats(rsv[m]);
                float* const yo = yout + (size_t)(row0 + ai * 128 + m * 16) * DM + col0;
#pragma unroll
                for (int bj = 0; bj < 2; ++bj)
#pragma unroll
                    for (int n = 0; n < 2; ++n) __builtin_nontemporal_store((acc[ai][bj][m][n] * rs.x - rs.y) * gv[bj][n] + bv[bj][n], (f32x4*)(yo + bj * 128 + n * 16));
            }
        }
    }
};
struct EpiWin {
    static constexpr bool PERM = false, AFTER_DRAIN = false, PF = true;
    unsigned char* ws; unsigned char* outb;
    __device__ __forceinline__ const float* pf_stats() const { return (const float*)(ws + CW_ST1); }
    __device__ __forceinline__ const float* pf_vec0() const { return (const float*)(ws + CW_CSIN); }
    __device__ __forceinline__ const float* pf_vec1() const { return (const float*)(ws + CW_BBIN); }
    __device__ __forceinline__ void operator()(const f32x4 (&accr)[2][2][4][2], const pg8::Unit& u, int wr, int wc, int fr, int fq, const LAS unsigned char* ops) const {
        const int pn = u.pn;
        f32x4 csv[2][2], bbv[2][2];
#pragma unroll
        for (int bj = 0; bj < 2; ++bj)
#pragma unroll
            for (int n = 0; n < 2; ++n) { const unsigned nn = bj * 128u + 32u * wc + 16u * n + 4u * fq;
                csv[bj][n] = *(const LAS f32x4*)(ops + 2048u + nn * 4u); bbv[bj][n] = *(const LAS f32x4*)(ops + 3072u + nn * 4u); }
#define WST8(off, v) (*(u32x2*)(ws + (unsigned)(off)) = (v))
#define WSTB16(off, a_, b_) do { const u32x2 a__ = pk4(a_), b__ = pk4(b_); *(u32x4*)(ws + (unsigned)(off)) = (u32x4){a__.x, a__.y, b__.x, b__.y}; } while (0)
#define WST16(off, v) (*(f32x4*)(ws + (unsigned)(off)) = (v))
#define OST16(off, v) (*(f32x4*)(outb + (unsigned)(off)) = (v))
#pragma unroll
        for (int ai = 0; ai < 2; ++ai) {
            f32x2 rsv[4];
#pragma unroll
            for (int m = 0; m < 4; ++m) rsv[m] = *(const LAS f32x2*)(ops + (unsigned)(ai * 128 + wr * 64 + m * 16 + fr) * 8u);
#pragma unroll
            for (int m = 0; m < 4; ++m) {
                int row = u.pm * 256 + ai * 128 + wr * 64 + m * 16 + fr;
                asm volatile("" : "+v"(row));
                const bool rok = row < MROWS;
                const unsigned pidx = row < MP ? (unsigned)(row & 2047) : 2048u;
                f32x4 acc[2][2]; { const f32x2 rs_ = ln_stats(rsv[m]); const float rstd = rs_.x, rm = rs_.y;
#pragma unroll
                    for (int bj = 0; bj < 2; ++bj)
#pragma unroll
                        for (int n = 0; n < 2; ++n) acc[bj][n] = accr[ai][bj][m][n] * rstd - csv[bj][n] * rm + bbv[bj][n]; }
                if (pn < 12) {
#pragma unroll
                    for (int bj = 0; bj < 2; ++bj) {
                        f32x4 v0 = acc[bj][0], v1 = acc[bj][1];
                        if (pn < 10 && wc == 0) {
                            const unsigned ro = (unsigned)WS_ROPEA + (pidx * 16u + 4u * fq) * 8u;
                            const f32x4 ra = *(const f32x4*)(ws + ro), rb = *(const f32x4*)(ws + ro + 16u);
                            const float c[4] = {ra[0], ra[2], rb[0], rb[2]}, s[4] = {ra[1], ra[3], rb[1], rb[3]};
#pragma unroll
                            for (int j = 0; j < 4; ++j) { const float x1 = v0[j], x2 = v1[j]; v0[j] = x1 * c[j] - x2 * s[j]; v1[j] = x2 * c[j] + x1 * s[j]; }
                        }
                        if (rok) {
                            const bool nat = pn < 10 && wc == 0;
                            const unsigned d0 = nat ? 4u * fq : 32u * wc + 8u * fq, d1 = nat ? 16u : 4u;
                            if (pn < 8) { const unsigned o = (unsigned)WS_Q + ((unsigned)row * DM + (2u * pn + bj) * 128u + d0) * 2u;
                                if (nat) { WST8(o, pk4(v0 * QSCALE)); WST8(o + 32u, pk4(v1 * QSCALE)); } else WSTB16(o, v0 * QSCALE, v1 * QSCALE); }
                            else { const unsigned kvh = 2u * ((pn - 8) & 1) + bj; const bool isk = pn < 10;
                                const unsigned fo = (row < MP ? (unsigned)(isk ? O_KP : O_VP) + (unsigned)row * 512u : (unsigned)(isk ? O_KS : O_VS) + (unsigned)(row - MP) * 512u) + kvh * 128u + d0;
                                OST16(fo * 4u, v0); OST16((fo + d1) * 4u, v1);
                                const unsigned bo = (unsigned)(isk ? WS_KB : WS_VB) + ((unsigned)row * 512u + kvh * 128u + d0) * 2u;
                                if (nat) { WST8(bo, pk4(v0)); WST8(bo + 32u, pk4(v1)); } else WSTB16(bo, v0, v1); }
                        }
                    }
                } else if (pn < 16) {
#pragma unroll
                    for (int bj = 0; bj < 2; ++bj) {
                        f32x4 v0 = acc[bj][0]; const f32x4 v1 = acc[bj][1];
                        if ((wc & 1) == 0) {
                            const unsigned ro = (unsigned)WS_ROPEI + (pidx * 8u + 4u * (fq & 1)) * 8u;
                            const f32x4 ra = *(const f32x4*)(ws + ro), rb = *(const f32x4*)(ws + ro + 16u);
                            const float c[4] = {ra[0], ra[2], rb[0], rb[2]}, s[4] = {ra[1], ra[3], rb[1], rb[3]};
#pragma unroll
                            for (int j = 0; j < 4; ++j) { const float own = v0[j], oth = __shfl_xor(own, 32); v0[j] = (fq < 2) ? own * c[j] - oth * s[j] : own * c[j] + oth * s[j]; }
                        }
                        if (rok) {
                            const bool nat = (wc & 1) == 0;
                            const unsigned ih = 4u * (pn - 12) + 2u * bj + (wc >> 1), d0 = nat ? 4u * fq : 32u + 8u * fq, d1 = nat ? 16u : 4u;
                            const unsigned o = (unsigned)WS_QI + ((unsigned)row * 1024u + ih * 64u + d0) * 2u;
                            if (nat) { WST8(o, pk4(v0)); WST8(o + 32u, pk4(v1)); } else WSTB16(o, v0, v1);
                            if (row >= MP) { const unsigned fo = (unsigned)WS_QIS + ((unsigned)(row - MP) * 1024u + ih * 64u + d0) * 4u; WST16(fo, v0); WST16(fo + d1 * 4u, v1); }
                        }
                    }
                } else if (pn < 40) {
                    if (rok) {
#pragma unroll
                        for (int bj = 0; bj < 2; ++bj) { const unsigned col = (unsigned)(pn - 16) * 256u + bj * 128u + 32u * wc + 8u * fq;
                            WSTB16((unsigned)WS_RAW + ((unsigned)row * CONVD + col) * 2u, acc[bj][0], acc[bj][1]);
                            if (row >= MP) { const unsigned fo = ((unsigned)O_CONVS + ((unsigned)(row - MP) * 3u + 2u) * CONVD + col) * 4u; OST16(fo, acc[bj][0]); OST16(fo + 16u, acc[bj][1]); }
                            else if ((row & 2047) >= 2045) { const unsigned fo = ((unsigned)O_CONVP + ((unsigned)(row >> 11) * 3u + (unsigned)((row & 2047) - 2045)) * CONVD + col) * 4u; OST16(fo, acc[bj][0]); OST16(fo + 16u, acc[bj][1]); } }
                    }
                } else if (pn < 64) {
                    if (rok) {
                        const unsigned dbase = (unsigned)((pn < 48) ? WS_ZS : (pn < 56) ? WS_GA : WS_GB);
#pragma unroll
                        for (int bj = 0; bj < 2; ++bj) { const unsigned col = (unsigned)((pn - 40) & 7) * 256u + bj * 128u + 32u * wc + 8u * fq;
                            if (pn < 48) WSTB16(dbase + ((unsigned)row * DM + col) * 2u, silu4(acc[bj][0]), silu4(acc[bj][1]));
                            else WSTB16(dbase + ((unsigned)row * DM + col) * 2u, acc[bj][0], acc[bj][1]); }
                    }
                } else {
                    f32x4 v0 = acc[0][0]; const f32x4 v1 = acc[0][1];
                    if (wc == 0) {
                        const unsigned ro = (unsigned)WS_ROPEI + (pidx * 8u + 4u * (fq & 1)) * 8u;
                        const f32x4 ra = *(const f32x4*)(ws + ro), rb = *(const f32x4*)(ws + ro + 16u);
                        const float c[4] = {ra[0], ra[2], rb[0], rb[2]}, s[4] = {ra[1], ra[3], rb[1], rb[3]};
#pragma unroll
                        for (int j = 0; j < 4; ++j) { const float own = v0[j], oth = __shfl_xor(own, 32); v0[j] = (fq < 2) ? own * c[j] - oth * s[j] : own * c[j] + oth * s[j]; }
                    }
                    if (rok) {
                        if (wc < 2) { const unsigned d0 = 32u * wc + 4u * fq;
                            const unsigned fo = (row < MP ? (unsigned)O_IKP + (unsigned)row * 64u : (unsigned)O_IKS + (unsigned)(row - MP) * 64u) + d0; OST16(fo * 4u, v0); OST16(fo * 4u + 64u, v1);
                            const unsigned bo = (unsigned)WS_KI + ((unsigned)row * 64u + d0) * 2u; WST8(bo, pk4(v0)); WST8(bo + 32u, pk4(v1)); }
                        else if (wc == 2) {
                            WST16((unsigned)WS_WIDX + ((unsigned)row * 16u + 4u * fq) * 4u, v0 * 0.03125f);
                            f32x4 g;
                            unsigned go = (unsigned)CW_GDNA + 16u * fq; asm volatile("" : "+v"(go));
                            const f32x4 na = *(const f32x4*)(ws + go), db = *(const f32x4*)(ws + go + 64u);
#pragma unroll
                            for (int j = 0; j < 4; ++j) { const float xx = v1[j] + db[j]; const float sp = fmaxf(xx, 0.f) + __logf(1.f + __expf(-fabsf(xx))); g[j] = na[j] * sp; }
                            WST16((unsigned)WS_GDEC + ((unsigned)row * 16u + 4u * fq) * 4u, g); }
                        else { WST16((unsigned)WS_BETA + ((unsigned)row * 16u + 4u * fq) * 4u, sigm4(v0)); }
                    }
                }
            }
        }
#undef WST8
#undef WSTB16
#undef WST16
#undef OST16
    }
};

__device__ __forceinline__ float wave_sum(float v) {
#pragma unroll
    for (int o = 1; o < 64; o <<= 1) v += __shfl_xor(v, o);
    return v;
}
__device__ __forceinline__ void ln_phase(const float* src, const float* g, const float* b, float* dst_p, float* dst_s, bf16* dstb, int row_begin) {
    const int tid = otid(), lane = tid & 63, wid = tid >> 6;
    const int gw = blockIdx.x * 8 + wid, NGW = gridDim.x * 8;
    for (int row0 = row_begin + gw; row0 < MROWS; row0 += 2 * NGW) {
        const int row1 = row0 + NGW; const bool two = row1 < MROWS;
        f32x4 v[2][8];
#pragma unroll
        for (int j = 0; j < 8; ++j) v[0][j] = *(const f32x4*)(src + (size_t)row0 * DM + j * 256 + lane * 4);
#pragma unroll
        for (int j = 0; j < 8; ++j) v[1][j] = *(const f32x4*)(src + (size_t)(two ? row1 : row0) * DM + j * 256 + lane * 4);
#pragma unroll
        for (int q = 0; q < 2; ++q) {
            if (q == 1 && !two) break;
            const int row = q ? row1 : row0;
            float s = 0.f;
#pragma unroll
            for (int j = 0; j < 8; ++j) s += (v[q][j][0] + v[q][j][1]) + (v[q][j][2] + v[q][j][3]);
            const float mean = wave_sum(s) * (1.f / DM); float s2 = 0.f;
#pragma unroll
            for (int j = 0; j < 8; ++j) { v[q][j] = v[q][j] - mean; s2 += (v[q][j][0] * v[q][j][0] + v[q][j][1] * v[q][j][1]) + (v[q][j][2] * v[q][j][2] + v[q][j][3] * v[q][j][3]); }
            const float rstd = 1.0f / sqrtf(wave_sum(s2) * (1.f / DM) + 1e-5f);
            float* of = row < MP ? dst_p + (size_t)row * DM : dst_s + (size_t)(row - MP) * DM;
#pragma unroll
            for (int j = 0; j < 8; ++j) { const f32x4 gg = *(const f32x4*)(g + j * 256 + lane * 4), bb = *(const f32x4*)(b + j * 256 + lane * 4);
                const f32x4 o = v[q][j] * rstd * gg + bb; *(f32x4*)(of + j * 256 + lane * 4) = o;
                if (dstb) *(u32x2*)(dstb + (size_t)row * DM + j * 256 + lane * 4) = pk4(o); }
        }
    }
}

template <int MODE>
__device__ __forceinline__ void skinny_phase(const bf16* A, const bf16* Bt, int N, int K, unsigned char* ws, const float* xin, const float* lg, const float* lb, float scale, LAS unsigned char* lds) {
    constexpr bool RLN = MODE != 0, OUTB = MODE != 2;
    float* const out = (float*)(ws + WS_PRE) + (size_t)MP * DM; bf16* const outb = (bf16*)(ws + WS_X1B) + (size_t)MP * DM;
    const float* const res = RLN ? (const float*)(ws + WS_PRE) + (size_t)MP * DM : xin;
    const float* const sto = (const float*)(ws + (MODE == 1 ? CW_ST1 : CW_ST2)) + (size_t)MP * 2; float* const stn = (float*)(ws + (MODE == 0 ? CW_ST1 : CW_ST2)) + (size_t)MP * 2;
    const float alpha = DN_ALPHA;
    const int tid = otid(), lane = tid & 63, wid = tid >> 6, fr = lane & 15, fq = lane >> 4;
    LAS f32x4* red = (LAS f32x4*)lds;
    const int kper = K / 8, k0 = wid * kper, nsteps = kper / 32;
    for (int item = blockIdx.x; item < N / 16; item += gridDim.x) {
        const int n0 = item * 16;
        const bf16* wp = Bt + (size_t)(n0 + fr) * K + k0 + 8 * fq;
        const bf16* ap = A + (size_t)(fr & 7) * K + k0 + 8 * fq;
        f32x4 acc = {0.f, 0.f, 0.f, 0.f};
#pragma unroll 4
        for (int s = 0; s < nsteps; ++s) {
            const bf16x8 wf = *(const bf16x8*)(wp + s * 32);
            bf16x8 af = *(const bf16x8*)(ap + s * 32);
            if (fr >= 8) af = (bf16x8){0, 0, 0, 0, 0, 0, 0, 0};
            acc = __builtin_amdgcn_mfma_f32_16x16x32_bf16(wf, af, acc, 0, 0, 0);
        }
        __syncthreads();
        red[wid * 64 + lane] = acc;
        __syncthreads();
        if (wid == 0) {
            f32x4 t = red[lane];
#pragma unroll
            for (int w = 1; w < 8; ++w) t += red[w * 64 + lane];
            const int d = fr & 7;
            const int cl = (MODE == 2) ? n0 + 4 * fq : (n0 & ~31) + 8 * fq + 4 * ((n0 >> 4) & 1);
            const size_t o = (size_t)d * DM + cl;
            f32x4 xr = *(const f32x4*)(res + o);
            if constexpr (RLN) { const f32x2 rs = ln_row(sto, d); xr = (xr * rs.x - rs.y) * *(const f32x4*)(lg + cl) + *(const f32x4*)(lb + cl); }
            const f32x4 v = xr * alpha + t * scale;
            if (fr < 8) *(f32x4*)(out + o) = v;
            if constexpr (OUTB) {
                if (fr < 8) *(u32x2*)(outb + o) = pk4(v);
                float s1 = (v[0] + v[1]) + (v[2] + v[3]), s2 = (v[0] * v[0] + v[1] * v[1]) + (v[2] * v[2] + v[3] * v[3]);
                s1 += __shfl_xor(s1, 16); s1 += __shfl_xor(s1, 32); s2 += __shfl_xor(s2, 16); s2 += __shfl_xor(s2, 32);
                if (lane < 8) { atomicAdd(stn + (size_t)d * 2, s1); atomicAdd(stn + (size_t)d * 2 + 1, s2); }
            }
        }
    }
}

__device__ __forceinline__ void conv_row(const P& p, int row) {
    const int tid = otid();
    const bf16* RAW = (const bf16*)(p.ws + WS_RAW);
    bf16* QH = (bf16*)(p.ws + WS_QH); bf16* KH = (bf16*)(p.ws + WS_KH); bf16* VH = (bf16*)(p.ws + WS_VH);
    {
        const int t = row & 2047;
#pragma unroll
        for (int part = 0; part < 3; ++part) {
            const int ch = part * 2048 + tid * 4;
            f32x4 y = {0.f, 0.f, 0.f, 0.f};
#pragma unroll
            for (int j = 0; j < 4; ++j) {
                const f32x4 w = *(const f32x4*)(p.convw + (size_t)j * CONVD + ch);
                f32x4 x;
                if (row < MP) { if (t - 3 + j < 0) x = (f32x4){0.f, 0.f, 0.f, 0.f}; else x = unpk4(*(const u32x2*)(RAW + (size_t)(row - 3 + j) * CONVD + ch)); }
                else { const int d = row - MP; x = (j < 3) ? *(const f32x4*)(p.state_conv + ((size_t)d * 3 + j) * CONVD + ch) : *(const f32x4*)(p.out + O_CONVS + ((size_t)d * 3 + 2) * CONVD + ch); }
                y += w * x;
            }
            f32x4 s = silu4(y);
            if (part < 2) {
                float ss = (s[0] * s[0] + s[1] * s[1]) + (s[2] * s[2] + s[3] * s[3]);
#pragma unroll
                for (int o = 1; o < 32; o <<= 1) ss += __shfl_xor(ss, o);
                const float sc = (1.0f / sqrtf(ss + 1e-6f)) * (part == 0 ? 0.08838834764831845f : 1.f);
                s = s * sc;
            }
            bf16* dst = (part == 0 ? QH : part == 1 ? KH : VH) + (size_t)row * DM + tid * 4;
            *(u32x2*)dst = pk4(s);
        }
    }
}

__device__ __forceinline__ void gdn_naive_phase(const P& p, LAS unsigned char* lds, int first_wg, int ngrp) {
    const int tid = otid(), dv = tid & 127, kg = tid >> 7;
    const bf16* QH = (const bf16*)(p.ws + WS_QH); const bf16* KH = (const bf16*)(p.ws + WS_KH); const bf16* VH = (const bf16*)(p.ws + WS_VH);
    const float* GDEC = (const float*)(p.ws + WS_GDEC); const float* BETA = (const float*)(p.ws + WS_BETA); bf16* OB = (bf16*)(p.ws + WS_OB);
    LAS float* kq = (LAS float*)lds;
    LAS float* red = kq + 256;
    LAS float* red2 = red + 512;
    for (int item = ((int)blockIdx.x >= first_wg && (int)blockIdx.x < first_wg + ngrp) ? 64 + (int)blockIdx.x - first_wg : 192; item < 192; item += ngrp) {
        const int seq = item >> 4, h = item & 15;
        const int T = seq < 4 ? SEQ : 1, row0 = seq < 4 ? seq * SEQ : MP + (seq - 4);
        float S[32];
        if (seq < 4) {
#pragma unroll
            for (int i = 0; i < 32; ++i) S[i] = 0.f;
        } else {
#pragma unroll
            for (int i = 0; i < 32; ++i) S[i] = p.state_ssm[(((size_t)(seq - 4) * 16 + h) * 128 + 32 * kg + i) * 128 + dv];
        }
        for (int t = 0; t < T; ++t) {
            const int row = row0 + t;
            __syncthreads();
            if (tid < 256) kq[tid] = bf2f((tid < 128 ? KH : QH)[(size_t)row * DM + h * 128 + (tid & 127)]);
            const float gd = __expf(GDEC[row * 16 + h]), beta = BETA[row * 16 + h];
            const float v = bf2f(VH[(size_t)row * DM + h * 128 + dv]);
            __syncthreads();
            float part = 0.f;
#pragma unroll
            for (int i = 0; i < 32; ++i) { S[i] *= gd; part += kq[32 * kg + i] * S[i]; }
            red[kg * 128 + dv] = part;
            __syncthreads();
            const float kS = (red[dv] + red[128 + dv]) + (red[256 + dv] + red[384 + dv]);
            const float vn = beta * (v - kS);
            float op = 0.f;
#pragma unroll
            for (int i = 0; i < 32; ++i) { S[i] += kq[32 * kg + i] * vn; op += kq[128 + 32 * kg + i] * S[i]; }
            red2[kg * 128 + dv] = op;
            __syncthreads();
            if (kg == 0) OB[(size_t)row * DM + h * 128 + dv] = (bf16)(pkbf((red2[dv] + red2[128 + dv]) + (red2[256 + dv] + red2[384 + dv]), 0.f) & 0xffffu);
        }
        float* so = seq < 4 ? p.out + O_SSMP + ((size_t)seq * 16 + h) * 16384 : p.out + O_SSMS + ((size_t)(seq - 4) * 16 + h) * 16384;
#pragma unroll
        for (int i = 0; i < 32; ++i) so[(size_t)(32 * kg + i) * 128 + dv] = S[i];
    }
}

__device__ __forceinline__ void merge_phase(const P& p) {
    const int tid = otid(), lane = tid & 63, wid = tid >> 6;
    const int gw = blockIdx.x * 8 + wid, NGW = gridDim.x * 8;
    const bf16* OA = (const bf16*)(p.ws + WS_OA); const bf16* OB = (const bf16*)(p.ws + WS_OB);
    const bf16* ZS = (const bf16*)(p.ws + WS_ZS); const bf16* GA = (const bf16*)(p.ws + WS_GA); const bf16* GB = (const bf16*)(p.ws + WS_GB);
    bf16* MRG = (bf16*)(p.ws + WS_MRG);
    const f32x4 gn = *(const f32x4*)(p.gng + (lane & 31) * 4);
    for (int row = gw; row < MROWS; row += NGW) {
#pragma unroll
        for (int pass = 0; pass < 8; ++pass) {
            const size_t o = (size_t)row * DM + (2 * pass + (lane >> 5)) * 128 + (lane & 31) * 4;
            const f32x4 ob = unpk4(*(const u32x2*)(OB + o));
            float ss = (ob[0] * ob[0] + ob[1] * ob[1]) + (ob[2] * ob[2] + ob[3] * ob[3]);
#pragma unroll
            for (int s = 1; s < 32; s <<= 1) ss += __shfl_xor(ss, s);
            const float r = 1.0f / sqrtf(ss * (1.f / 128.f) + 1e-6f);
            const f32x4 zs = unpk4(*(const u32x2*)(ZS + o)), ga = sigm4(unpk4(*(const u32x2*)(GA + o))), gb = sigm4(unpk4(*(const u32x2*)(GB + o))), oa = unpk4(*(const u32x2*)(OA + o));
            const f32x4 mr = ga * oa + gb * (ob * r * gn * zs);
            *(u32x2*)(MRG + o) = pk4(mr);
        }
    }
}

#define MFMA32(a, b, c) __builtin_amdgcn_mfma_f32_32x32x16_bf16(a, b, c, 0, 0, 0)

__device__ __forceinline__ unsigned ord_u32(float v) { const unsigned b = __builtin_bit_cast(unsigned, v); return (b & 0x80000000u) ? ~b : (b | 0x80000000u); }

__device__ __forceinline__ void idx_select_row(const float* SC, unsigned* MASK, int row, int lane) {
    const int t = row & 2047;
    unsigned* mrow = MASK + (size_t)row * 64;
    if (t < 256) {
        if (lane < 32) { u32x2 w;
#pragma unroll
            for (int e = 0; e < 2; ++e) { const int lo = 32 * (2 * lane + e); w[e] = (lo + 31 <= t) ? 0xffffffffu : (lo > t) ? 0u : ((1u << (t - lo + 1)) - 1u); }
            *(u32x2*)(mrow + 2 * lane) = w; }
        return;
    }
    const float* srow = SC + (size_t)row * SEQ;
    unsigned u[32];
    {   float sv[32];
#pragma unroll
        for (int i = 0; i < 32; ++i) sv[i] = (i * 64 <= t) ? srow[i * 64 + lane] : 0.f;
#pragma unroll
        for (int i = 0; i < 32; ++i) u[i] = (i * 64 + lane <= t) ? ord_u32(sv[i]) : 0u;
    }
    unsigned tau = 0u;
    for (int bit = 31; bit >= 0; --bit) {
        const unsigned cand = tau | (1u << bit); int cnt = 0;
#pragma unroll
        for (int g = 0; g < 4; ++g) {
            unsigned long long mk[8];
#pragma unroll
            for (int j = 0; j < 8; ++j) mk[j] = __ballot(u[8 * g + j] >= cand);
            __builtin_amdgcn_sched_barrier(0);
#pragma unroll
            for (int j = 0; j < 8; ++j) cnt += __popcll(mk[j]);
            __builtin_amdgcn_sched_barrier(0);
        }
        if (cnt >= 256) tau = cand;
        if (cnt == 256) break;
    }
    unsigned long long mine = 0ull;
#pragma unroll
    for (int i = 0; i < 32; ++i) { const unsigned long long bal = __ballot(u[i] >= tau); if (lane == i) mine = bal; }
    if (lane < 32) *(unsigned long long*)(mrow + 2 * lane) = mine;
}

__device__ __forceinline__ void idx_item(const P& p, LAS unsigned char* lds, int item) {
    const int tid = otid(), lane = tid & 63, wid = tid >> 6, r32 = lane & 31, hi = lane >> 5;
    const bf16* QI = (const bf16*)(p.ws + WS_QI); const bf16* KI = (const bf16*)(p.ws + WS_KI); const float* WIDX = (const float*)(p.ws + WS_WIDX);
    float* SC = (float*)(p.ws + WS_SC); unsigned* MASK = (unsigned*)(p.ws + WS_MASK);
    {
        const int b = item & 3, qb = item < 224 ? 63 - (item >> 2) : (item - 224) >> 2;
        const int rowbase = b * SEQ, t0 = qb * 32;
        if (qb >= 8) {
            lds_barrier();
            {
                u32x4 qv[8]; f32x4 wq = {0.f, 0.f, 0.f, 0.f};
#pragma unroll
                for (int i = 0; i < 8; ++i) { const int c = tid + 512 * i; qv[i] = *(const u32x4*)(QI + (size_t)(rowbase + t0 + (c >> 7)) * 1024 + (c & 127) * 8); }
                if (tid < 128) wq = *(const f32x4*)(WIDX + (size_t)(rowbase + t0) * 16 + tid * 4);
#pragma unroll
                for (int i = 0; i < 8; ++i) { const int c = tid + 512 * i; *(LAS u32x4*)(lds + (c >> 7) * 2064 + (c & 127) * 16) = qv[i]; }
                if (tid < 128) *(LAS f32x4*)(lds + 32 * 2064 + tid * 16) = wq;
            }
            lds_barrier();
            const int npair = (qb + 2) >> 1;
            for (int kp = wid; kp < npair; kp += 8) {
                bf16x8 a[2][4];
#pragma unroll
                for (int e = 0; e < 2; ++e)
#pragma unroll
                    for (int kk = 0; kk < 4; ++kk) a[e][kk] = *(const bf16x8*)(KI + (size_t)(rowbase + min(2 * kp + e, qb) * 32 + r32) * 64 + kk * 16 + hi * 8);
                f32x16 sc[2];
#pragma unroll
                for (int q = 0; q < 16; ++q) { sc[0][q] = 0.f; sc[1][q] = 0.f; }
#pragma unroll 1
                for (int hg = 0; hg < 8; ++hg) {
                    bf16x8 bq[2][4];
#pragma unroll
                    for (int h2 = 0; h2 < 2; ++h2)
#pragma unroll
                        for (int kk = 0; kk < 4; ++kk) bq[h2][kk] = *(const LAS bf16x8*)(lds + r32 * 2064 + (2 * hg + h2) * 128 + kk * 32 + hi * 16);
                    const f32x2 wv = *(const LAS f32x2*)(lds + 32 * 2064 + (r32 * 16 + 2 * hg) * 4);
#pragma unroll
                    for (int e = 0; e < 2; ++e) {
                        f32x16 d0, d1;
#pragma unroll
                        for (int q = 0; q < 16; ++q) { d0[q] = 0.f; d1[q] = 0.f; }
#pragma unroll
                        for (int kk = 0; kk < 4; ++kk) { d0 = MFMA32(a[e][kk], bq[0][kk], d0); d1 = MFMA32(a[e][kk], bq[1][kk], d1); }
#pragma unroll
                        for (int q = 0; q < 16; ++q) sc[e][q] += wv.x * relu_fast(d0[q]) + wv.y * relu_fast(d1[q]);
                    }
                }
#pragma unroll
                for (int e = 0; e < 2; ++e) {
                    const int kb = 2 * kp + e;
                    if (kb <= qb) { float* dst = SC + (size_t)(rowbase + t0 + r32) * SEQ + kb * 32 + 4 * hi;
#pragma unroll
                        for (int g = 0; g < 4; ++g) *(f32x4*)(dst + 8 * g) = (f32x4){sc[e][4 * g], sc[e][4 * g + 1], sc[e][4 * g + 2], sc[e][4 * g + 3]}; }
                }
            }
            __builtin_amdgcn_fence(__ATOMIC_RELEASE, "workgroup");
            __syncthreads();
            __builtin_amdgcn_fence(__ATOMIC_ACQUIRE, "workgroup");
        }
#pragma unroll 1
        for (int rr = 0; rr < 4; ++rr) idx_select_row(SC, MASK, rowbase + t0 + wid * 4 + rr, lane);
    }
}

__device__ __forceinline__ bf16x8 cat8(s16x4 lo, s16x4 hi) { return (bf16x8){lo[0], lo[1], lo[2], lo[3], hi[0], hi[1], hi[2], hi[3]}; }
constexpr int AT_KP = 272, AT_VP = 320, AT_KB = 64 * AT_KP, AT_VB = 64 * AT_VP;
template <int OFF> __device__ __forceinline__ s16x4 tr_read(unsigned addr) { s16x4 r; asm volatile("ds_read_b64_tr_b16 %0, %1 offset:%2" : "=&v"(r) : "v"(addr), "i"(OFF) : "memory"); return r; }

__device__ __forceinline__ void attn_unit(const P& p, LAS unsigned char* lds, int b, int kvh, int qb) {
    const int tid = otid(), lane = tid & 63, wid = tid >> 6, r32 = lane & 31, hi = lane >> 5;
    const bf16* Q = (const bf16*)(p.ws + WS_Q); const bf16* KBp = (const bf16*)(p.ws + WS_KB); const bf16* VBp = (const bf16*)(p.ws + WS_VB);
    const unsigned* MASK = (const unsigned*)(p.ws + WS_MASK); bf16* OA = (bf16*)(p.ws + WS_OA);
    const int g = wid >> 1, head = 4 * kvh + g, q0 = 64 * qb + 32 * (wid & 1);
    const size_t rowq = (size_t)b * SEQ + q0 + r32;
    bf16x8 qf[8];
#pragma unroll
    for (int kk = 0; kk < 8; ++kk) qf[kk] = *(const bf16x8*)(Q + rowq * DM + head * 128 + kk * 16 + hi * 8);
    f32x16 o[4];
#pragma unroll
    for (int mt = 0; mt < 4; ++mt)
#pragma unroll
        for (int r = 0; r < 16; ++r) o[mt][r] = 0.f;
    float mrun = -1e30f, lrun = 0.f;
    const int ntiles = qb + 1;
    const int srow = tid >> 3, sch = tid & 7;
    const bf16* kg = KBp + ((size_t)b * SEQ + srow) * 512 + kvh * 128 + sch * 16;
    const bf16* vg = VBp + ((size_t)b * SEQ + srow) * 512 + kvh * 128 + sch * 16;
    LAS unsigned char* Kl = lds; LAS unsigned char* Vl = lds + 2 * AT_KB;
    u32x4 sk0, sk1, sv0, sv1;
    sk0 = *(const u32x4*)kg; sk1 = *(const u32x4*)(kg + 8); sv0 = *(const u32x4*)vg; sv1 = *(const u32x4*)(vg + 8);
    lds_barrier();
    *(LAS u32x4*)(Kl + srow * AT_KP + sch * 32) = sk0; *(LAS u32x4*)(Kl + srow * AT_KP + sch * 32 + 16) = sk1;
    *(LAS u32x4*)(Vl + srow * AT_VP + sch * 32) = sv0; *(LAS u32x4*)(Vl + srow * AT_VP + sch * 32 + 16) = sv1;
    lds_barrier();
    u32x2 mwn = *(const u32x2*)(MASK + rowq * 64);
    const unsigned vlane = (unsigned)((4 * hi + ((lane >> 2) & 3)) * AT_VP + (16 * ((lane >> 4) & 1) + 4 * (lane & 3)) * 2);
    for (int tile = 0; tile < ntiles; ++tile) {
        const int buf = tile & 1;
        const u32x2 mw = mwn;
        if (tile + 1 < ntiles) { const size_t go = (size_t)(tile + 1) * 64 * 512; mwn = *(const u32x2*)(MASK + rowq * 64 + 2 * (tile + 1));
            sk0 = *(const u32x4*)(kg + go); sk1 = *(const u32x4*)(kg + go + 8); sv0 = *(const u32x4*)(vg + go); sv1 = *(const u32x4*)(vg + go + 8); }
        const LAS unsigned char* Kb = Kl + buf * AT_KB;
        f32x16 p0, p1;
#pragma unroll
        for (int r = 0; r < 16; ++r) { p0[r] = 0.f; p1[r] = 0.f; }
        {
            bf16x8 ka[4], kb2[4], kc[4], kd[4];
#pragma unroll
            for (int kk = 0; kk < 4; ++kk) { ka[kk] = *(const LAS bf16x8*)(Kb + r32 * AT_KP + kk * 32 + hi * 16); kb2[kk] = *(const LAS bf16x8*)(Kb + (32 + r32) * AT_KP + kk * 32 + hi * 16); }
            __builtin_amdgcn_sched_barrier(0);
#pragma unroll
            for (int kk = 0; kk < 4; ++kk) { kc[kk] = *(const LAS bf16x8*)(Kb + r32 * AT_KP + (kk + 4) * 32 + hi * 16); kd[kk] = *(const LAS bf16x8*)(Kb + (32 + r32) * AT_KP + (kk + 4) * 32 + hi * 16); }
#pragma unroll
            for (int kk = 0; kk < 4; ++kk) { p0 = MFMA32(ka[kk], qf[kk], p0); p1 = MFMA32(kb2[kk], qf[kk], p1); }
            __builtin_amdgcn_sched_barrier(0);
#pragma unroll
            for (int kk = 0; kk < 4; ++kk) { p0 = MFMA32(kc[kk], qf[kk + 4], p0); p1 = MFMA32(kd[kk], qf[kk + 4], p1); }
        }
        const unsigned w0 = mw.x >> (4 * hi), w1 = mw.y >> (4 * hi);
        float mt_ = p0[0];
#pragma unroll
        for (int r = 0; r < 16; ++r) mt_ = __builtin_amdgcn_fmed3f(mt_, p0[r], __builtin_inff()), mt_ = __builtin_amdgcn_fmed3f(mt_, p1[r], __builtin_inff());
        mt_ = fmaxf(mt_, __shfl_xor(mt_, 32));
        if (__any(mt_ > mrun + 8.f)) {
            const float mnew = fmaxf(mrun, mt_), alpha = fexp2(mrun - mnew); mrun = mnew;
            lrun *= alpha;
#pragma unroll
            for (int mt = 0; mt < 4; ++mt)
#pragma unroll
                for (int r = 0; r < 16; ++r) o[mt][r] *= alpha;
        }
        float ps = 0.f;
#pragma unroll
        for (int r = 0; r < 16; ++r) { const int bp = (r & 3) + 8 * (r >> 2);
            const float e0 = fexp2(p0[r] - mrun), e1 = fexp2(p1[r] - mrun);
            p0[r] = __builtin_bit_cast(float, __builtin_bit_cast(unsigned, e0) & (unsigned)__builtin_amdgcn_sbfe((int)w0, bp, 1));
            p1[r] = __builtin_bit_cast(float, __builtin_bit_cast(unsigned, e1) & (unsigned)__builtin_amdgcn_sbfe((int)w1, bp, 1));
            ps += p0[r] + p1[r]; }
        lrun += ps;
        bf16x8 pb[4];
#pragma unroll
        for (int c = 0; c < 4; ++c) {
            u32x4 w;
            if (c < 2) { w.x = pkbf(p0[8 * c], p0[8 * c + 1]); w.y = pkbf(p0[8 * c + 2], p0[8 * c + 3]); w.z = pkbf(p0[8 * c + 4], p0[8 * c + 5]); w.w = pkbf(p0[8 * c + 6], p0[8 * c + 7]); }
            else { const int cc = c - 2; w.x = pkbf(p1[8 * cc], p1[8 * cc + 1]); w.y = pkbf(p1[8 * cc + 2], p1[8 * cc + 3]); w.z = pkbf(p1[8 * cc + 4], p1[8 * cc + 5]); w.w = pkbf(p1[8 * cc + 6], p1[8 * cc + 7]); }
            pb[c] = __builtin_bit_cast(bf16x8, w);
        }
        const unsigned vb = (unsigned)(size_t)(Vl + buf * AT_VB) + vlane;
#define AT_RD(S, MT) { S[0] = tr_read<(0) * AT_VP + 64 * (MT)>(vb); S[1] = tr_read<(8) * AT_VP + 64 * (MT)>(vb); S[2] = tr_read<(16) * AT_VP + 64 * (MT)>(vb); S[3] = tr_read<(24) * AT_VP + 64 * (MT)>(vb); \
            S[4] = tr_read<(32) * AT_VP + 64 * (MT)>(vb); S[5] = tr_read<(40) * AT_VP + 64 * (MT)>(vb); S[6] = tr_read<(48) * AT_VP + 64 * (MT)>(vb); S[7] = tr_read<(56) * AT_VP + 64 * (MT)>(vb); }
#define AT_WAIT(S, N) asm volatile("s_waitcnt lgkmcnt(" #N ")" : "+v"(S[0]), "+v"(S[1]), "+v"(S[2]), "+v"(S[3]), "+v"(S[4]), "+v"(S[5]), "+v"(S[6]), "+v"(S[7]) :: "memory")
#define AT_MM(S, MT) { o[MT] = MFMA32(cat8(S[0], S[1]), pb[0], o[MT]); o[MT] = MFMA32(cat8(S[2], S[3]), pb[1], o[MT]); o[MT] = MFMA32(cat8(S[4], S[5]), pb[2], o[MT]); o[MT] = MFMA32(cat8(S[6], S[7]), pb[3], o[MT]); }
        {   s16x4 va[8], vc[8];
            AT_RD(va, 0) AT_RD(vc, 1) AT_WAIT(va, 8); AT_MM(va, 0)
            AT_RD(va, 2) AT_WAIT(vc, 8); AT_MM(vc, 1)
            AT_RD(vc, 3) AT_WAIT(va, 8); AT_MM(va, 2)
            AT_WAIT(vc, 0); AT_MM(vc, 3)
        }
#undef AT_RD
#undef AT_WAIT
#undef AT_MM
        if (tile + 1 < ntiles) {
            LAS unsigned char* Kn = Kl + (buf ^ 1) * AT_KB; LAS unsigned char* Vn = Vl + (buf ^ 1) * AT_VB;
            *(LAS u32x4*)(Kn + srow * AT_KP + sch * 32) = sk0; *(LAS u32x4*)(Kn + srow * AT_KP + sch * 32 + 16) = sk1;
            *(LAS u32x4*)(Vn + srow * AT_VP + sch * 32) = sv0; *(LAS u32x4*)(Vn + srow * AT_VP + sch * 32 + 16) = sv1;
        }
        lds_barrier();
    }
    lrun += __shfl_xor(lrun, 32);
    const float inv = 1.0f / lrun;
    bf16* op = OA + rowq * DM + head * 128 + 8 * hi;
#pragma unroll
    for (int mt = 0; mt < 4; ++mt)
#pragma unroll
        for (int q2 = 0; q2 < 2; ++q2) {
            const u32x2 a0 = pk4((f32x4){o[mt][8 * q2], o[mt][8 * q2 + 1], o[mt][8 * q2 + 2], o[mt][8 * q2 + 3]} * inv), a1 = pk4((f32x4){o[mt][8 * q2 + 4], o[mt][8 * q2 + 5], o[mt][8 * q2 + 6], o[mt][8 * q2 + 7]} * inv);
            const u32x2 snd = hi ? a0 : a1;
            const u32x2 rcv = {(unsigned)__shfl_xor((int)snd.x, 32), (unsigned)__shfl_xor((int)snd.y, 32)};
            *(u32x4*)(op + 32 * mt + 16 * q2) = hi ? (u32x4){rcv.x, rcv.y, a1.x, a1.y} : (u32x4){a0.x, a0.y, rcv.x, rcv.y};
        }
}
__device__ __forceinline__ void attn_phase(const P& p, LAS unsigned char* lds, int qsel) {
    unsigned* qhead = (unsigned*)(p.ws + WS_CTL + 49152 + qsel * 256);
    volatile LAS unsigned* slot = (volatile LAS unsigned*)(lds + LDS_MISC + 64);
    const int tid = otid();
    for (;;) {
        __syncthreads();
        if (tid == 0) *slot = __hip_atomic_fetch_add(qhead, 1u, __ATOMIC_RELAXED, __HIP_MEMORY_SCOPE_AGENT);
        __syncthreads();
        const unsigned u = *slot;
        if (u >= 512u) break;
        const int bk = (int)(u & 15u), qb = 31 - (int)(u >> 4);
        attn_unit(p, lds, bk >> 2, bk & 3, qb);
    }
}

__device__ __forceinline__ void smp_scores_item(const P& p, LAS unsigned char* lds, int item) {
    const int tid = otid();
    const float* QIS = (const float*)(p.ws + WS_QIS); const float* WIDX = (const float*)(p.ws + WS_WIDX); float* SCS = (float*)(p.ws + WS_SCS);
    LAS float* ql = (LAS float*)lds;
    {
        const bool isnew = item >= 256; const int d = isnew ? item - 256 : item >> 5;
        const float* krow;
        int kidx;
        if (!isnew) { const int pg = (item & 31) * 4 + (tid >> 7); krow = p.cache_ik + ((size_t)p.page_table[d * 128 + pg] * 128 + (tid & 127)) * 64; kidx = pg * 128 + (tid & 127); }
        else { krow = p.out + O_IKS + (size_t)d * 64; kidx = PAST; }
        f32x4 kv[16];
#pragma unroll
        for (int c = 0; c < 16; ++c) kv[c] = __builtin_nontemporal_load((const f32x4*)(krow + c * 4));
        lds_barrier();
        for (int c = tid; c < 1024; c += 512) ql[c] = QIS[(size_t)d * 1024 + c];
        if (tid < 16) ql[1024 + tid] = WIDX[(size_t)(MP + d) * 16 + tid];
        lds_barrier();
        float sc = 0.f;
#pragma unroll 2
        for (int h = 0; h < 16; ++h) { float dot = 0.f;
#pragma unroll
            for (int c = 0; c < 16; ++c) { const f32x4 qv = *(const LAS f32x4*)(ql + h * 64 + c * 4); dot += (kv[c][0] * qv[0] + kv[c][1] * qv[1]) + (kv[c][2] * qv[2] + kv[c][3] * qv[3]); }
            sc += ql[1024 + h] * fmaxf(dot, 0.f); }
        if (!isnew || tid == 0) SCS[(size_t)d * 16640 + kidx] = sc;
    }
}
__device__ __forceinline__ void smp_select_item(const P& p, LAS unsigned char* lds, int item) {
    const int tid = otid(), lane = tid & 63, wid = tid >> 6;
    const float* SCS = (const float*)(p.ws + WS_SCS); int* SELS = (int*)(p.ws + WS_SELS);
    LAS int* cnts = (LAS int*)lds;
    LAS int* nsel = cnts + 16;
    {   const int d = item >> 2;
        __syncthreads();
        unsigned u[33];
#pragma unroll
        for (int i = 0; i < 33; ++i) { const int k = i * 512 + tid; const float sv = SCS[(size_t)d * 16640 + (k < 16640 ? k : 16639)]; u[i] = (k <= PAST) ? ord_u32(sv) : 0u; }
        if (tid == 0) *nsel = 0;
        unsigned tau = 0u;
        for (int bit = 31; bit >= 0; --bit) {
            const unsigned cand = tau | (1u << bit); int c = 0;
#pragma unroll
            for (int i = 0; i < 33; ++i) c += (u[i] >= cand) ? 1 : 0;
#pragma unroll
            for (int o = 1; o < 64; o <<= 1) c += __shfl_xor(c, o);
            LAS int* cb = cnts + (bit & 1) * 8;
            if (lane == 0) cb[wid] = c;
            __syncthreads();
            int tot = 0;
#pragma unroll
            for (int w = 0; w < 8; ++w) tot += cb[w];
            if (tot >= 256) tau = cand;
            if (tot == 256) break;
        }
        __syncthreads();
#pragma unroll
        for (int i = 0; i < 33; ++i) if (u[i] >= tau) { const int pos = atomicAdd((int*)nsel, 1); if (pos < 256) SELS[item * 256 + pos] = i * 512 + tid; }
        __syncthreads();
    }
}
__device__ __forceinline__ void smp_attn_item(const P& p, LAS unsigned char* lds, int item) {
    const int tid = otid(), lane = tid & 63, wid = tid >> 6;
    const bf16* Q = (const bf16*)(p.ws + WS_Q); const int* SELS = (const int*)(p.ws + WS_SELS); bf16* OA = (bf16*)(p.ws + WS_OA);
    LAS float* ql = (LAS float*)lds;
    LAS float* sc = ql + 512;
    LAS float* red = sc + 1024;
    LAS int* rofs = (LAS int*)(red + 2048);
    {   const int d = item >> 2, kvh = item & 3;
        __syncthreads();
        ql[tid] = bf2f(Q[(size_t)(MP + d) * DM + kvh * 512 + tid]);
        if (tid < 256) { const int idx = SELS[item * 256 + tid]; rofs[tid] = (idx < PAST) ? p.page_table[d * 128 + (idx >> 7)] * 128 + (idx & 127) : -1; }
        __syncthreads();
        {   const int j = tid >> 1, hf = tid & 1, ro = rofs[j];
            const float* kr = (ro >= 0) ? p.cache_k + ((size_t)ro * 4 + kvh) * 128 : p.out + O_KS + ((size_t)d * 4 + kvh) * 128;
            f32x4 kv[16];
#pragma unroll
            for (int c = 0; c < 16; ++c) kv[c] = __builtin_nontemporal_load((const f32x4*)(kr + hf * 64 + c * 4));
#pragma unroll
            for (int g = 0; g < 4; ++g) { float dot = 0.f;
#pragma unroll
                for (int c = 0; c < 16; ++c) { const f32x4 qv = *(const LAS f32x4*)(ql + g * 128 + hf * 64 + c * 4); dot += (kv[c][0] * qv[0] + kv[c][1] * qv[1]) + (kv[c][2] * qv[2] + kv[c][3] * qv[3]); }
                dot += __shfl_xor(dot, 1);
                if (hf == 0) sc[g * 256 + j] = dot; }
        }
        __syncthreads();
        if (wid < 4) { float v[4]; float mx = -INFINITY;
#pragma unroll
            for (int e = 0; e < 4; ++e) { v[e] = sc[wid * 256 + e * 64 + lane]; mx = fmaxf(mx, v[e]); }
#pragma unroll
            for (int o = 1; o < 64; o <<= 1) mx = fmaxf(mx, __shfl_xor(mx, o));
            float sm = 0.f;
#pragma unroll
            for (int e = 0; e < 4; ++e) { v[e] = fexp2(v[e] - mx); sm += v[e]; }
            sm = wave_sum(sm); const float inv = 1.0f / sm;
#pragma unroll
            for (int e = 0; e < 4; ++e) sc[wid * 256 + e * 64 + lane] = v[e] * inv; }
        __syncthreads();
        {   const int dd = tid & 127, jg = tid >> 7; float acc[4] = {0.f, 0.f, 0.f, 0.f};
#pragma unroll 1
            for (int j0 = 0; j0 < 64; j0 += 16) {
                float vv[16];
#pragma unroll
                for (int e = 0; e < 16; ++e) { const int ro = rofs[jg * 64 + j0 + e];
                    const float* vr = (ro >= 0) ? p.cache_v + ((size_t)ro * 4 + kvh) * 128 : p.out + O_VS + ((size_t)d * 4 + kvh) * 128;
                    vv[e] = __builtin_nontemporal_load(vr + dd); }
#pragma unroll
                for (int e = 0; e < 16; ++e)
#pragma unroll
                    for (int g = 0; g < 4; ++g) acc[g] += sc[g * 256 + jg * 64 + j0 + e] * vv[e];
            }
#pragma unroll
            for (int g = 0; g < 4; ++g) red[(jg * 4 + g) * 128 + dd] = acc[g];
        }
        __syncthreads();
        {   const int g = tid >> 7, dd = tid & 127;
            const float s = (red[(0 * 4 + g) * 128 + dd] + red[(1 * 4 + g) * 128 + dd]) + (red[(2 * 4 + g) * 128 + dd] + red[(3 * 4 + g) * 128 + dd]);
            OA[(size_t)(MP + d) * DM + (4 * kvh + g) * 128 + dd] = (bf16)(pkbf(s, 0.f) & 0xffffu); }
    }
}

#define MFMA16(a, b, c) __builtin_amdgcn_mfma_f32_16x16x32_bf16(a, b, c, 0, 0, 0)
constexpr size_t GW_ITEM = 73728, GW_WN = 0, GW_U = 16384, GW_QG = 32768, GW_KT = 49152, GW_QK = 65536;
constexpr int GW_SPLIT = 1290;
__device__ __forceinline__ unsigned char* gw_item(unsigned char* ws, int it) { return ws + (it < GW_SPLIT ? WS_H + (size_t)it * GW_ITEM : WS_X1 + (size_t)(it - GW_SPLIT) * GW_ITEM); }
constexpr size_t WS_GL = WS_CTL + 32768;
static_assert((size_t)GW_SPLIT * GW_ITEM <= (size_t)MPAD * DFF * 2 && (size_t)(2048 - GW_SPLIT) * GW_ITEM <= (size_t)MPAD * DM * 4, "GDN chunk records must fit in H and x1");
constexpr int G1_CW = 0, G1_GS = 6144, G1_BS = 6400, G1_KS = 6656, G1_QS = 24064, G1_RHS = 41472, G1_LB = 78336, G1_LD = 87552, G1_TB = 92672;
constexpr int G1_KP = 272, G1_RP = 576, G1_TP = 144;

__device__ __forceinline__ s16x4 tr_read_o(unsigned addr) { s16x4 r; asm volatile("ds_read_b64_tr_b16 %0, %1" : "=&v"(r) : "v"(addr) : "memory"); return r; }

constexpr int G1_NCH = 4;
__device__ __forceinline__ void g1_item(const P& p, LAS unsigned char* lds, int wg) {
    const int tid = otid(), lane = tid & 63, wid = tid >> 6, fr = lane & 15, fq = lane >> 4;
    const bf16* RAW = (const bf16*)(p.ws + WS_RAW);
    const float* GDEC = (const float*)(p.ws + WS_GDEC); const float* BETA = (const float*)(p.ws + WS_BETA);
    float* GLp = (float*)(p.ws + WS_GL);
    LAS float* GS = (LAS float*)(lds + G1_GS); LAS float* BS = (LAS float*)(lds + G1_BS);
    {
        const int h = wg & 15, b = (wg >> 4) & 3, cg0 = (wg >> 6) * G1_NCH;
        __syncthreads();
        for (int e = tid; e < 3 * 4 * 32; e += 512) { const int part = e / 128, rem = e % 128, j = rem >> 5, c4 = rem & 31;
            *(LAS f32x4*)(lds + G1_CW + ((part * 4 + j) * 128 + c4 * 4) * 4) = *(const f32x4*)(p.convw + (size_t)j * CONVD + part * 2048 + h * 128 + c4 * 4); }
        float g_nx = 0.f, b_nx = 0.f;
        if (wid == 0) { const int r0 = b * SEQ + cg0 * 64 + lane; g_nx = GDEC[(size_t)r0 * 16 + h]; b_nx = BETA[(size_t)r0 * 16 + h]; }
        u32x4 xa[4][2], xb[4][2], xc[4][2];
        const int t = tid >> 3, cg = tid & 7;
#define G1_LOADX(X, PART, C) { _Pragma("unroll") for (int j = 0; j < 4; ++j) { const int rr = (C) * 64 + t - 3 + j >= 0 ? b * SEQ + (C) * 64 + t - 3 + j : b * SEQ + (C) * 64 + t; \
                const bf16* xr = RAW + (size_t)rr * CONVD + (PART) * 2048 + h * 128 + cg * 16; X[j][0] = *(const u32x4*)xr; X[j][1] = *(const u32x4*)(xr + 8); } }
        for (int ci = 0; ci < G1_NCH; ++ci) {
            const int c = cg0 + ci, it = (b * 16 + h) * 32 + c;
            const int row0 = b * SEQ + c * 64;
            unsigned char* gw = gw_item(p.ws, it);
            const int trow = c * 64 + t;
            G1_LOADX(xa, 0, c) G1_LOADX(xb, 1, c) G1_LOADX(xc, 2, c)
            lds_barrier();
            if (wid == 0) {
                float g = g_nx; const float bb = b_nx;
                if (ci + 1 < G1_NCH) { g_nx = GDEC[(size_t)(row0 + 64 + lane) * 16 + h]; b_nx = BETA[(size_t)(row0 + 64 + lane) * 16 + h]; }
#pragma unroll
                for (int o = 1; o < 64; o <<= 1) { const float v = __shfl_up(g, o); if (lane >= o) g += v; }
                GS[lane] = g; BS[lane] = bb;
                if (lane == 63) GLp[it] = __expf(g);
            }
            lds_barrier();
            {
                const float bt = BS[t], Gt = GS[t], eG = __expf(Gt), eGl = __expf(GS[63] - Gt);
                f32x4 s[3][4];
#define G1_CONV(X, PART) { f32x4 y[4]; _Pragma("unroll") for (int q = 0; q < 4; ++q) y[q] = (f32x4){0.f, 0.f, 0.f, 0.f}; \
                    _Pragma("unroll") for (int j = 0; j < 4; ++j) { const float on = (trow - 3 + j >= 0) ? 1.f : 0.f; \
                        const LAS f32x4* wv = (const LAS f32x4*)(lds + G1_CW + (((PART) * 4 + j) * 128 + cg * 16) * 4); \
                        y[0] += wv[0] * on * unpk4((u32x2){X[j][0].x, X[j][0].y}); y[1] += wv[1] * on * unpk4((u32x2){X[j][0].z, X[j][0].w}); \
                        y[2] += wv[2] * on * unpk4((u32x2){X[j][1].x, X[j][1].y}); y[3] += wv[3] * on * unpk4((u32x2){X[j][1].z, X[j][1].w}); } \
                    float ss = 0.f; \
                    _Pragma("unroll") for (int q = 0; q < 4; ++q) { s[PART][q] = silu4(y[q]); ss += (s[PART][q][0] * s[PART][q][0] + s[PART][q][1] * s[PART][q][1]) + (s[PART][q][2] * s[PART][q][2] + s[PART][q][3] * s[PART][q][3]); } \
                    if ((PART) < 2) { ss += __shfl_xor(ss, 1); ss += __shfl_xor(ss, 2); ss += __shfl_xor(ss, 4); \
                        const float sc = (1.0f / sqrtf(ss + 1e-6f)) * ((PART) == 0 ? 0.08838834764831845f : 1.f); \
                        _Pragma("unroll") for (int q = 0; q < 4; ++q) s[PART][q] = s[PART][q] * sc; } }
                G1_CONV(xa, 0)
                G1_CONV(xb, 1)
                G1_CONV(xc, 2)
#undef G1_CONV
#define G1_PK16(dst, v, sc) { u32x4 w0, w1; w0.x = pkbf(v[0][0] * (sc), v[0][1] * (sc)); w0.y = pkbf(v[0][2] * (sc), v[0][3] * (sc)); w0.z = pkbf(v[1][0] * (sc), v[1][1] * (sc)); w0.w = pkbf(v[1][2] * (sc), v[1][3] * (sc)); \
                    w1.x = pkbf(v[2][0] * (sc), v[2][1] * (sc)); w1.y = pkbf(v[2][2] * (sc), v[2][3] * (sc)); w1.z = pkbf(v[3][0] * (sc), v[3][1] * (sc)); w1.w = pkbf(v[3][2] * (sc), v[3][3] * (sc)); \
                    *(dst) = w0; *((dst) + 1) = w1; }
                G1_PK16((LAS u32x4*)(lds + G1_QS + t * G1_KP + cg * 32), s[0], 1.f)
                G1_PK16((LAS u32x4*)(lds + G1_KS + t * G1_KP + cg * 32), s[1], 1.f)
                G1_PK16((LAS u32x4*)(lds + G1_RHS + t * G1_RP + cg * 32), s[2], bt)
                G1_PK16((LAS u32x4*)(lds + G1_RHS + t * G1_RP + 256 + cg * 32), s[1], bt * eG)
                G1_PK16((u32x4*)(gw + GW_QG + t * 256 + cg * 32), s[0], eG)
                G1_PK16((u32x4*)(gw + GW_KT + t * 256 + cg * 32), s[1], eGl)
#undef G1_PK16
#undef G1_LOADX
            }
            lds_barrier();
            for (int job = wid; job < 20; job += 8) {
                const bool isqk = job >= 10; const int jj = isqk ? job - 10 : job;
                int hiT = 0, loT = 0;
                if (jj >= 6) { hiT = 3; loT = jj - 6; } else if (jj >= 3) { hiT = 2; loT = jj - 3; } else if (jj >= 1) { hiT = 1; loT = jj - 1; }
                const LAS unsigned char* Ab = lds + G1_KS + (16 * loT + fr) * G1_KP + fq * 16;
                const LAS unsigned char* Bb = lds + (isqk ? G1_QS : G1_KS) + (16 * hiT + fr) * G1_KP + fq * 16;
                f32x4 d = {0.f, 0.f, 0.f, 0.f};
#pragma unroll
                for (int kk = 0; kk < 4; ++kk) d = MFMA16(*(const LAS bf16x8*)(Ab + kk * 64), *(const LAS bf16x8*)(Bb + kk * 64), d);
                const int i = 16 * hiT + fr; const float Gi = GS[i]; f32x4 o;
                if (!isqk) {
                    const float bi = BS[i];
#pragma unroll
                    for (int r = 0; r < 4; ++r) { const int j = 16 * loT + 4 * fq + r; o[r] = (i > j) ? bi * d[r] * __expf(Gi - GS[j]) : 0.f; }
                    *(LAS u32x2*)(lds + G1_LB + i * G1_TP + (16 * loT + 4 * fq) * 2) = pk4(o);
                    if (hiT == loT) *(LAS f32x4*)(lds + G1_LD + ((hiT * 16 + fr) * 20 + 4 * fq) * 4) = o;
                } else {
#pragma unroll
                    for (int r = 0; r < 4; ++r) { const int j = 16 * loT + 4 * fq + r; o[r] = (i >= j) ? d[r] * __expf(Gi - GS[j]) : 0.f; }
                    *(u32x2*)(gw + GW_QK + i * 128 + (16 * loT + 4 * fq) * 2) = pk4(o);
                }
            }
            if (tid < 384) { const int tp = tid >> 6, l2 = tid & 63;
                int iT = 0, jT = 1; if (tp == 1) jT = 2; else if (tp == 2) jT = 3; else if (tp == 3) { iT = 1; jT = 2; } else if (tp == 4) { iT = 1; jT = 3; } else if (tp == 5) { iT = 2; jT = 3; }
                *(u32x2*)(gw + GW_QK + (16 * iT + (l2 & 15)) * 128 + (16 * jT + 4 * (l2 >> 4)) * 2) = (u32x2){0u, 0u}; }
            lds_barrier();
            if (wid == 0) {
                const int blk = lane >> 4, i = lane & 15;
                const LAS float* ld = (const LAS float*)(lds + G1_LD + blk * 16 * 20 * 4);
                float T[16];
                T[15] = (i == 15) ? 1.f : 0.f;
#pragma unroll
                for (int j = 14; j >= 0; --j) {
                    float a = (i == j) ? 1.f : 0.f;
#pragma unroll
                    for (int k = j + 1; k < 16; ++k) a -= T[k] * ld[k * 20 + j];
                    T[j] = a;
                }
                u32x4 w0, w1; w0.x = pkbf(T[0], T[1]); w0.y = pkbf(T[2], T[3]); w0.z = pkbf(T[4], T[5]); w0.w = pkbf(T[6], T[7]);
                w1.x = pkbf(T[8], T[9]); w1.y = pkbf(T[10], T[11]); w1.z = pkbf(T[12], T[13]); w1.w = pkbf(T[14], T[15]);
                *(LAS u32x4*)(lds + G1_TB + lane * 32) = w0; *(LAS u32x4*)(lds + G1_TB + lane * 32 + 16) = w1;
            }
            lds_barrier();
            {
                typedef short s4 __attribute__((ext_vector_type(4)));
                s4 aT[4], aL[6];
#pragma unroll
                for (int bq = 0; bq < 4; ++bq) aT[bq] = *(const LAS s4*)(lds + G1_TB + (bq * 16 + fr) * 32 + fq * 8);
#pragma unroll
                for (int ib = 1; ib < 4; ++ib)
#pragma unroll
                    for (int jb = 0; jb < ib; ++jb) { u32x2 w = *(const LAS u32x2*)(lds + G1_LB + (16 * ib + fr) * G1_TP + (16 * jb + 4 * fq) * 2);
                        w.x ^= 0x80008000u; w.y ^= 0x80008000u; aL[ib * (ib - 1) / 2 + jb] = __builtin_bit_cast(s4, w); }
#pragma unroll
                for (int ct = 0; ct < 2; ++ct) {
                    const int c0 = 32 * wid + 16 * ct;
                    LAS unsigned char* rb = lds + G1_RHS + (4 * fq) * G1_RP + (c0 + fr) * 2;
                    s4 xb[3];
#pragma unroll
                    for (int ib = 0; ib < 4; ++ib) {
                        f32x4 acc;
#pragma unroll
                        for (int r = 0; r < 4; ++r) acc[r] = bf2f(*(const LAS unsigned short*)(rb + (16 * ib + r) * G1_RP));
#pragma unroll
                        for (int jb = 0; jb < ib; ++jb) acc = __builtin_amdgcn_mfma_f32_16x16x16bf16_1k(aL[ib * (ib - 1) / 2 + jb], xb[jb], acc, 0, 0, 0);
                        const s4 ab = __builtin_bit_cast(s4, pk4(acc));
                        const f32x4 x = __builtin_amdgcn_mfma_f32_16x16x16bf16_1k(aT[ib], ab, (f32x4){0.f, 0.f, 0.f, 0.f}, 0, 0, 0);
                        const u32x2 xp = pk4(x);
                        if (ib < 3) xb[ib] = __builtin_bit_cast(s4, xp);
                        if (c0 < 128) {
                            *(u32x2*)(gw + GW_U + (size_t)(((c0 >> 4) * 4 + ib) * 64 + lane) * 8) = xp;
                        } else {
                            const u32x2 xs = pk4(-x);
                            *(LAS unsigned short*)(rb + (16 * ib + 0) * G1_RP) = (unsigned short)(xs.x & 0xffffu); *(LAS unsigned short*)(rb + (16 * ib + 1) * G1_RP) = (unsigned short)(xs.x >> 16);
                            *(LAS unsigned short*)(rb + (16 * ib + 2) * G1_RP) = (unsigned short)(xs.y & 0xffffu); *(LAS unsigned short*)(rb + (16 * ib + 3) * G1_RP) = (unsigned short)(xs.y >> 16);
                        }
                    }
                }
            }
            lds_barrier();
#pragma unroll
            for (int i4 = 0; i4 < 2; ++i4) { const int q = tid + 512 * i4, row = q >> 4, ch = q & 15;
                const u32x4 v = *(const LAS u32x4*)(lds + G1_RHS + row * G1_RP + 256 + ch * 16);
                *(u32x4*)(gw + GW_WN + row * 256 + ch * 16) = v; }
        }
    }
}

constexpr int SC_WN = 0, SC_QG = 17408, SC_KT = 34816, SC_QK = 52224, SC_U = 61440, SC_BUF = 77824, SC_P = 272, SC_QP = 144, SC_NLD = 18;
__device__ __forceinline__ void gdn_scan_stage(LAS unsigned char* buf, const u32x4 (&st)[SC_NLD], int lt) {
    LAS unsigned char* const b16 = buf + (lt >> 4) * SC_P + (lt & 15) * 16;
    LAS unsigned char* const bu = buf + SC_U + lt * 16;
    LAS unsigned char* const bq = buf + SC_QK + (lt >> 3) * SC_QP + (lt & 7) * 16;
#pragma unroll
    for (int i = 0; i < SC_NLD; ++i) {
        if (i < 4) *(LAS u32x4*)(b16 + SC_WN + 16 * i * SC_P) = st[i];
        else if (i < 8) *(LAS u32x4*)(bu + (i - 4) * 4096) = st[i];
        else if (i < 16) *(LAS u32x4*)(b16 + (i < 12 ? SC_QG : SC_KT) + 16 * (i & 3) * SC_P) = st[i];
        else *(LAS u32x4*)(bq + 32 * (i - 16) * SC_QP) = st[i]; }
}
__device__ __forceinline__ void gdn_scan_load(u32x4 (&st)[SC_NLD], const unsigned char* gw, int lt) {
#pragma unroll
    for (int i = 0; i < SC_NLD; ++i) st[i] = *(const u32x4*)(gw + (size_t)i * 4096 + (unsigned)(lt * 16));
}
#define SC_FRAG(dst, base, pitch, row, col) { const LAS unsigned char* a_ = (base) + (row) * (pitch) + (col) * 2; const u32x2 x0_ = *(const LAS u32x2*)a_, x1_ = *(const LAS u32x2*)(a_ + 32); dst = (u32x4){x0_.x, x0_.y, x1_.x, x1_.y}; }
__device__ __forceinline__ void gdn_scan_item(const P& p, LAS unsigned char* lds, int bh) {
    const int tid = otid(), lane = tid & 63, wid = tid >> 6, fr = lane & 15, fq = lane >> 4;
    const int b = bh >> 4, h = bh & 15;
    __syncthreads();
    if (wid >= 4) {
        const int lt = tid - 256;
        u32x4 sa[SC_NLD], sb[SC_NLD];
        gdn_scan_load(sa, gw_item(p.ws, bh * 32), lt);
        gdn_scan_load(sb, gw_item(p.ws, bh * 32 + 1), lt);
        gdn_scan_stage(lds, sa, lt);
        gdn_scan_load(sa, gw_item(p.ws, bh * 32 + 2), lt);
        lds_barrier();
#define SC_LSTEP(R, C) { if ((C) + 1 < 32) gdn_scan_stage(lds + (((C) + 1) & 1) * SC_BUF, R, lt); gdn_scan_load(R, gw_item(p.ws, bh * 32 + ((C) + 3 < 32 ? (C) + 3 : 31)), lt); lds_barrier(); }
#pragma unroll 1
        for (int c = 0; c < 32; c += 2) { SC_LSTEP(sb, c) SC_LSTEP(sa, c + 1) }
#undef SC_LSTEP
        return;
    }
    bf16* OB = (bf16*)(p.ws + WS_OB); const float* GLp = (const float*)(p.ws + WS_GL);
    const int dv0 = 32 * wid;
    f32x4 S[8][2];
#pragma unroll
    for (int m = 0; m < 8; ++m) { S[m][0] = (f32x4){0.f, 0.f, 0.f, 0.f}; S[m][1] = (f32x4){0.f, 0.f, 0.f, 0.f}; }
    int eglv = __builtin_bit_cast(int, GLp[bh * 32 + (lane & 31)]);
    asm volatile("s_waitcnt vmcnt(0)" : "+v"(eglv) :: "memory");
    lds_barrier();
#pragma unroll 1
    for (int c = 0; c < 32; ++c) {
        const float egl = __builtin_bit_cast(float, __builtin_amdgcn_readlane(eglv, c));
        const LAS unsigned char* buf = lds + (c & 1) * SC_BUF;
        bf16x8 bS[4][2];
#pragma unroll
        for (int kk = 0; kk < 4; ++kk)
#pragma unroll
            for (int dt = 0; dt < 2; ++dt) { u32x4 w; w.x = pkbf(S[2 * kk][dt][0], S[2 * kk][dt][1]); w.y = pkbf(S[2 * kk][dt][2], S[2 * kk][dt][3]);
                w.z = pkbf(S[2 * kk + 1][dt][0], S[2 * kk + 1][dt][1]); w.w = pkbf(S[2 * kk + 1][dt][2], S[2 * kk + 1][dt][3]); bS[kk][dt] = __builtin_bit_cast(bf16x8, w); }
        f32x4 vn[4][2], oo[4][2];
        u32x4 fa[4][2], fb[4][2];
        u32x2 un[4][2];
#pragma unroll
        for (int m = 0; m < 4; ++m)
#pragma unroll
            for (int dt = 0; dt < 2; ++dt) un[m][dt] = *(const LAS u32x2*)(buf + SC_U + (((2 * wid + dt) * 4 + m) * 64 + lane) * 8);
#pragma unroll
        for (int m = 0; m < 4; ++m)
#pragma unroll
            for (int k = 0; k < 2; ++k) SC_FRAG(fa[m][k], buf + SC_WN, SC_P, 16 * m + fr, 32 * k + 4 * fq)
#pragma unroll
        for (int m = 0; m < 4; ++m) { vn[m][0] = unpk4(un[m][0]); vn[m][1] = unpk4(un[m][1]); }
        __builtin_amdgcn_sched_barrier(0);
#pragma unroll
        for (int m = 0; m < 4; ++m)
#pragma unroll
            for (int k = 0; k < 2; ++k) SC_FRAG(fb[m][k], buf + SC_WN, SC_P, 16 * m + fr, 32 * (k + 2) + 4 * fq)
#pragma unroll
        for (int k = 0; k < 2; ++k)
#pragma unroll
            for (int m = 0; m < 4; ++m) { vn[m][0] = MFMA16(__builtin_bit_cast(bf16x8, fa[m][k]), bS[k][0], vn[m][0]); vn[m][1] = MFMA16(__builtin_bit_cast(bf16x8, fa[m][k]), bS[k][1], vn[m][1]); }
        __builtin_amdgcn_sched_barrier(0);
        const unsigned kl = (unsigned)(size_t)(buf + SC_KT) + (unsigned)((4 * fq + ((lane >> 2) & 3)) * SC_P + (lane & 3) * 8);
        s16x4 lo[4][2], hi4[4][2];
#pragma unroll
        for (int q = 0; q < 4; ++q)
#pragma unroll
            for (int k2 = 0; k2 < 2; ++k2) { lo[q][k2] = tr_read_o(kl + (32 * k2) * SC_P + q * 32); hi4[q][k2] = tr_read_o(kl + (32 * k2 + 16) * SC_P + q * 32); }
#pragma unroll
        for (int k = 0; k < 2; ++k)
#pragma unroll
            for (int m = 0; m < 4; ++m) { vn[m][0] = MFMA16(__builtin_bit_cast(bf16x8, fb[m][k]), bS[k + 2][0], vn[m][0]); vn[m][1] = MFMA16(__builtin_bit_cast(bf16x8, fb[m][k]), bS[k + 2][1], vn[m][1]); }
        asm volatile("s_waitcnt lgkmcnt(0)" : "+v"(lo[0][0]), "+v"(lo[0][1]), "+v"(lo[1][0]), "+v"(lo[1][1]), "+v"(lo[2][0]), "+v"(lo[2][1]), "+v"(lo[3][0]), "+v"(lo[3][1]),
                                              "+v"(hi4[0][0]), "+v"(hi4[0][1]), "+v"(hi4[1][0]), "+v"(hi4[1][1]), "+v"(hi4[2][0]), "+v"(hi4[2][1]), "+v"(hi4[3][0]), "+v"(hi4[3][1]) :: "memory");
        __builtin_amdgcn_sched_barrier(0);
        bf16x8 bV[2][2];
#pragma unroll
        for (int k2 = 0; k2 < 2; ++k2)
#pragma unroll
            for (int dt = 0; dt < 2; ++dt) { u32x4 w; w.x = pkbf(vn[2 * k2][dt][0], vn[2 * k2][dt][1]); w.y = pkbf(vn[2 * k2][dt][2], vn[2 * k2][dt][3]);
                w.z = pkbf(vn[2 * k2 + 1][dt][0], vn[2 * k2 + 1][dt][1]); w.w = pkbf(vn[2 * k2 + 1][dt][2], vn[2 * k2 + 1][dt][3]); bV[k2][dt] = __builtin_bit_cast(bf16x8, w); }
#pragma unroll
        for (int m = 0; m < 4; ++m)
#pragma unroll
            for (int k = 0; k < 2; ++k) SC_FRAG(fa[m][k], buf + SC_QG, SC_P, 16 * m + fr, 32 * k + 4 * fq)
#pragma unroll
        for (int q = 0; q < 4; ++q) { S[q][0] = S[q][0] * egl; S[q][1] = S[q][1] * egl;
#pragma unroll
            for (int k2 = 0; k2 < 2; ++k2) { const bf16x8 a = cat8(lo[q][k2], hi4[q][k2]); S[q][0] = MFMA16(a, bV[k2][0], S[q][0]); S[q][1] = MFMA16(a, bV[k2][1], S[q][1]); } }
        __builtin_amdgcn_sched_barrier(0);
#pragma unroll
        for (int q = 0; q < 4; ++q)
#pragma unroll
            for (int k2 = 0; k2 < 2; ++k2) { lo[q][k2] = tr_read_o(kl + (32 * k2) * SC_P + (4 + q) * 32); hi4[q][k2] = tr_read_o(kl + (32 * k2 + 16) * SC_P + (4 + q) * 32); }
        asm volatile("s_waitcnt lgkmcnt(0)" : "+v"(lo[0][0]), "+v"(lo[0][1]), "+v"(lo[1][0]), "+v"(lo[1][1]), "+v"(lo[2][0]), "+v"(lo[2][1]), "+v"(lo[3][0]), "+v"(lo[3][1]),
                                              "+v"(hi4[0][0]), "+v"(hi4[0][1]), "+v"(hi4[1][0]), "+v"(hi4[1][1]), "+v"(hi4[2][0]), "+v"(hi4[2][1]), "+v"(hi4[3][0]), "+v"(hi4[3][1]) :: "memory");
        __builtin_amdgcn_sched_barrier(0);
#pragma unroll
        for (int m = 0; m < 4; ++m)
#pragma unroll
            for (int k = 0; k < 2; ++k) SC_FRAG(fb[m][k], buf + SC_QG, SC_P, 16 * m + fr, 32 * (k + 2) + 4 * fq)
#pragma unroll
        for (int q = 0; q < 4; ++q) { S[4 + q][0] = S[4 + q][0] * egl; S[4 + q][1] = S[4 + q][1] * egl;
#pragma unroll
            for (int k2 = 0; k2 < 2; ++k2) { const bf16x8 a = cat8(lo[q][k2], hi4[q][k2]); S[4 + q][0] = MFMA16(a, bV[k2][0], S[4 + q][0]); S[4 + q][1] = MFMA16(a, bV[k2][1], S[4 + q][1]); } }
#pragma unroll
        for (int m = 0; m < 4; ++m) { oo[m][0] = (f32x4){0.f, 0.f, 0.f, 0.f}; oo[m][1] = (f32x4){0.f, 0.f, 0.f, 0.f}; }
#pragma unroll
        for (int k = 0; k < 2; ++k)
#pragma unroll
            for (int m = 0; m < 4; ++m) { oo[m][0] = MFMA16(bS[k][0], __builtin_bit_cast(bf16x8, fa[m][k]), oo[m][0]); oo[m][1] = MFMA16(bS[k][1], __builtin_bit_cast(bf16x8, fa[m][k]), oo[m][1]); }
        __builtin_amdgcn_sched_barrier(0);
#pragma unroll
        for (int m = 0; m < 4; ++m)
#pragma unroll
            for (int k = 0; k < 2; ++k) SC_FRAG(fa[m][k], buf + SC_QK, SC_QP, 16 * m + fr, 32 * k + 4 * fq)
#pragma unroll
        for (int k = 0; k < 2; ++k)
#pragma unroll
            for (int m = 0; m < 4; ++m) { oo[m][0] = MFMA16(bS[k + 2][0], __builtin_bit_cast(bf16x8, fb[m][k]), oo[m][0]); oo[m][1] = MFMA16(bS[k + 2][1], __builtin_bit_cast(bf16x8, fb[m][k]), oo[m][1]); }
        __builtin_amdgcn_sched_barrier(0);
#pragma unroll
        for (int k = 0; k < 2; ++k)
#pragma unroll
            for (int m = 0; m < 4; ++m) { oo[m][0] = MFMA16(bV[k][0], __builtin_bit_cast(bf16x8, fa[m][k]), oo[m][0]); oo[m][1] = MFMA16(bV[k][1], __builtin_bit_cast(bf16x8, fa[m][k]), oo[m][1]); }
        __builtin_amdgcn_sched_barrier(0);
#pragma unroll
        for (int m = 0; m < 4; ++m)
#pragma unroll
            for (int dt = 0; dt < 2; ++dt)
                *(u32x2*)(OB + (size_t)(b * SEQ + c * 64 + 16 * m + fr) * DM + h * 128 + dv0 + 16 * dt + 4 * fq) = pk4(oo[m][dt]);
        lds_barrier();
    }
    float* so = p.out + O_SSMP + (size_t)bh * 16384;
#pragma unroll
    for (int md = 0; md < 8; ++md)
#pragma unroll
        for (int dt = 0; dt < 2; ++dt)
#pragma unroll
            for (int r = 0; r < 4; ++r) so[(size_t)(16 * md + 4 * fq + r) * 128 + dv0 + 16 * dt + fr] = S[md][dt][r];
}
#undef SC_FRAG

enum { PH_PRO = 0, PH_GU1, PH_DN1, PH_WIN, PH_MIX1, PH_MIX3, PH_MRG, PH_WO, PH_GU2, PH_DN2, PH_LN3, PH_COUNT };

template <int PH> __device__ __forceinline__ void run_phase(const P& p, LAS unsigned char* lds) {
    unsigned char* ws = p.ws;
    if constexpr (PH == PH_PRO) p0_prologue(p, lds);
    float* const ST2 = (float*)(ws + CW_ST2);
    bf16* const PREB = (bf16*)(ws + WS_X1B);
    if constexpr (PH == PH_GU1) {
        pg8::Gemm g{(const bf16*)(ws + WS_XB), (const bf16*)(ws + WS_W1T), MPAD, NFF2, DM};
        pg8::StaticOrder S; S.init(MPAD, NFF2, gridDim.x, blockIdx.x);
        EpiSwiglu<false> E{(bf16*)(ws + WS_H), nullptr, nullptr, nullptr};
        pg8::gemm_phase<EpiSwiglu<false>, pg8::StaticOrder, true, true>(lds, g, S, E);
    }
    if constexpr (PH == PH_GU2) {
        pg8::Gemm g{PREB, (const bf16*)(ws + WS_W2T), MPAD, NFF2, DM};
        pg8::StaticOrder S; S.init(MPAD, NFF2, gridDim.x, blockIdx.x);
        EpiSwiglu<true> E{(bf16*)(ws + WS_H), ST2, (const float*)(ws + CW_CSGU), (const float*)(ws + CW_BBGU)};
        pg8::gemm_phase<EpiSwiglu<true>, pg8::StaticOrder, true, true>(lds, g, S, E);
    }
    if constexpr (PH == PH_DN1) {
        const bf16* Hh = (const bf16*)(ws + WS_H); const bf16* Wd = (const bf16*)(ws + WS_W1D);
        pg8::Gemm g{Hh, Wd, MP, DM, DFF};
        pg8::StaticOrder S; S.init(MP, DM, gridDim.x, blockIdx.x);
        EpiResid<0> E{ws, p.x_prompt, nullptr, nullptr, 0.5f};
        pg8::gemm_phase<EpiResid<0>, pg8::StaticOrder, true, true>(lds, g, S, E);
        skinny_phase<0>(Hh + (size_t)MP * DFF, Wd, DM, DFF, ws, p.x_sample, nullptr, nullptr, 0.5f, lds);
    }
    if constexpr (PH == PH_DN2) {
        const bf16* Hh = (const bf16*)(ws + WS_H); const bf16* Wd = (const bf16*)(ws + WS_W2D);
        pg8::Gemm g{Hh, Wd, MP, DM, DFF};
        pg8::StaticOrder S; S.init(MP, DM, gridDim.x, blockIdx.x);
        if (gridDim.x >= 256) {
            EpiLn3 E{ws, p.ln2g, p.ln2b, p.ln3g, p.ln3b, p.out + O_YP};
            pg8::gemm_phase<EpiLn3, pg8::StaticOrder, true, true>(lds, g, S, E);
        } else {
            EpiResid<2> E{ws, nullptr, p.ln2g, p.ln2b, 0.5f};
            pg8::gemm_phase<EpiResid<2>, pg8::StaticOrder, true, true>(lds, g, S, E);
        }
        skinny_phase<2>(Hh + (size_t)MP * DFF, Wd, DM, DFF, ws, nullptr, p.ln2g, p.ln2b, 0.5f, lds);
    }
    if constexpr (PH == PH_LN3) ln_phase((const float*)(ws + WS_PRE), p.ln3g, p.ln3b, p.out + O_YP, p.out + O_YS, nullptr, gridDim.x >= 256 ? MP : 0);
    if constexpr (PH == PH_WIN) {
        pg8::Gemm g{PREB, (const bf16*)(ws + WS_WIN), MPAD, NIN, DM};
        pg8::StaticOrder S; S.init(MPAD, NIN, gridDim.x, blockIdx.x);
        EpiWin E{ws, (unsigned char*)p.out};
        pg8::gemm_phase<EpiWin, pg8::StaticOrder, true, true>(lds, g, S, E);
    }
#ifndef PROBE_SUB
#define PROBE_SUB 0
#endif
    if constexpr (PH == PH_MIX1) {
        unsigned* qhead = (unsigned*)(ws + WS_CTL + 49152 + 512);
        volatile LAS unsigned* slot = (volatile LAS unsigned*)(lds + LDS_MISC + 64);
        constexpr unsigned Q_G1 = 256, Q_SMP = Q_G1 + 2048 / G1_NCH, Q_CONV = Q_SMP + 264, Q_W2 = Q_CONV + 8, N_W2 = (32 * 176 + 88 * 32 + 32 * 32) / 8, Q_END = Q_W2 + N_W2;
        const int t_ = otid();
        for (;;) {
            __syncthreads();
            if (t_ == 0) *slot = __hip_atomic_fetch_add(qhead, 1u, __ATOMIC_RELAXED, __HIP_MEMORY_SCOPE_AGENT);
            __syncthreads();
            const unsigned u = *slot;
            if (u >= Q_END) break;
            if (u < Q_G1) idx_item(p, lds, (int)u);
            else if (u < Q_SMP) g1_item(p, lds, (int)(u - Q_G1));
            else if (u < Q_CONV) smp_scores_item(p, lds, (int)(u - Q_SMP));
            else if (u < Q_W2) conv_row(p, MP + (int)(u - Q_CONV));
            else convert_ffn2(p, (int)(u - Q_W2) * 8 + (t_ >> 6), 1 << 30, t_ & 63);
        }
    }
    if constexpr (PH == PH_MIX3) {
        const bool big = gridDim.x >= 128;
        for (int bh = blockIdx.x; bh < 64; bh += gridDim.x) { gdn_scan_item(p, lds, bh); if constexpr (PROBE_SUB == 4) gdn_scan_item(p, lds, bh); }
        for (int item = (int)blockIdx.x - (big ? 64 : 0); item >= 0 && item < 32; item += gridDim.x) { smp_select_item(p, lds, item); smp_attn_item(p, lds, item); }
        gdn_naive_phase(p, lds, big ? 96 : 0, big ? 32 : (int)gridDim.x);
        attn_phase(p, lds, 0);
        if constexpr (PROBE_SUB == 6) attn_phase(p, lds, 1);
    }
    if constexpr (PH == PH_MRG) merge_phase(p);
    if constexpr (PH == PH_WO) {
        const bf16* Mr = (const bf16*)(ws + WS_MRG); const bf16* Wo = (const bf16*)(ws + WS_WO);
        pg8::Gemm g{Mr, Wo, MP, DM, DM};
        pg8::StaticOrder S; S.init(MP, DM, gridDim.x, blockIdx.x);
        EpiResid<1> E{ws, nullptr, p.ln1g, p.ln1b, 1.0f};
        pg8::gemm_phase<EpiResid<1>, pg8::StaticOrder, true, true>(lds, g, S, E);
        skinny_phase<1>(Mr + (size_t)MP * DM, Wo, DM, DM, ws, nullptr, p.ln1g, p.ln1b, 1.0f, lds);
    }
}

#ifndef MK_MULTI
#define MK_MULTI 0
#endif
#if MK_MULTI
template <int PH> __global__ void __launch_bounds__(512, 2) k_phase(P p) {
    extern __shared__ __attribute__((aligned(16))) unsigned char lds_raw[];
    run_phase<PH>(p, (LAS unsigned char*)lds_raw);
}
template <int PH> static void launch_phase(const P& p, int grid, hipStream_t stream) {
    static bool attr_done = false;
    if (!attr_done) { (void)hipFuncSetAttribute((const void*)k_phase<PH>, hipFuncAttributeMaxDynamicSharedMemorySize, LDS_BYTES); attr_done = true; }
    hipLaunchKernelGGL(k_phase<PH>, dim3(grid), dim3(512), LDS_BYTES, stream, p);
    hipError_t e = hipGetLastError();
    if (e != hipSuccess) fprintf(stderr, "kernel_launch: phase %d launch failed: %s\n", PH, hipGetErrorName(e));
}
#else
__global__ void __launch_bounds__(512, 2) k_fwd(P p) {
    extern __shared__ __attribute__((aligned(16))) unsigned char lds_raw[];
    LAS unsigned char* lds = (LAS unsigned char*)lds_raw;
    volatile LAS unsigned* misc = (volatile LAS unsigned*)(lds + LDS_MISC);
    if (threadIdx.x < 4) misc[threadIdx.x] = 0u;
    __syncthreads();
    XcdBarrier bar = xcd_barrier_post((unsigned*)(p.ws + WS_CTL), misc);
#ifndef PROBE_DOUBLE
#define PROBE_DOUBLE -1
#endif
#define RUNP(PH) { run_phase<PH>(p, lds); xcd_barrier(bar); if constexpr (PROBE_DOUBLE == PH) { run_phase<PH>(p, lds); xcd_barrier(bar); } }
    RUNP(PH_PRO) RUNP(PH_GU1) RUNP(PH_DN1) RUNP(PH_WIN) RUNP(PH_MIX1) RUNP(PH_MIX3) RUNP(PH_MRG) RUNP(PH_WO) RUNP(PH_GU2) RUNP(PH_DN2)
    run_phase<PH_LN3>(p, lds);
#undef RUNP
}
#endif

extern "C" void kernel_launch(void* const* d_in, const int* in_sizes, int n_in, void* d_out, int out_size, void* d_ws, size_t ws_size, hipStream_t stream) {
    if (n_in != 26 || out_size != (int)O_END || ws_size < WS_END) { fprintf(stderr, "kernel_launch: unexpected shapes: n_in %d out_size %d ws_size %zu (need %zu)\n", n_in, out_size, ws_size, (size_t)WS_END); return; }
    P p{};
    p.x_prompt = (const float*)d_in[0]; p.x_sample = (const float*)d_in[1]; p.cache_k = (const float*)d_in[2]; p.cache_v = (const float*)d_in[3]; p.cache_ik = (const float*)d_in[4];
    p.state_ssm = (const float*)d_in[5]; p.state_conv = (const float*)d_in[6]; p.page_table = (const int*)d_in[7];
    p.w1g = (const float*)d_in[8]; p.w1u = (const float*)d_in[9]; p.w1d = (const float*)d_in[10]; p.ln1g = (const float*)d_in[11]; p.ln1b = (const float*)d_in[12];
    p.win = (const float*)d_in[13]; p.convw = (const float*)d_in[14]; p.alog = (const float*)d_in[15]; p.dtb = (const float*)d_in[16]; p.gng = (const float*)d_in[17];
    p.wo = (const float*)d_in[18]; p.ln2g = (const float*)d_in[19]; p.ln2b = (const float*)d_in[20]; p.w2g = (const float*)d_in[21]; p.w2u = (const float*)d_in[22]; p.w2d = (const float*)d_in[23];
    p.ln3g = (const float*)d_in[24]; p.ln3b = (const float*)d_in[25];
    p.out = (float*)d_out; p.ws = (unsigned char*)d_ws;
    static int grid = 0;
    if (!grid) { int dev = 0, cus = 0; (void)hipGetDevice(&dev); (void)hipDeviceGetAttribute(&cus, hipDeviceAttributeMultiprocessorCount, dev); grid = cus > 0 ? cus : 256; }
    (void)hipMemsetAsync((char*)d_ws + WS_CTL, 0, CTL_BYTES, stream);
#if MK_MULTI
    launch_phase<PH_PRO>(p, grid, stream); launch_phase<PH_GU1>(p, grid, stream); launch_phase<PH_DN1>(p, grid, stream);
    launch_phase<PH_WIN>(p, grid, stream); launch_phase<PH_MIX1>(p, grid, stream); launch_phase<PH_MIX3>(p, grid, stream);
    launch_phase<PH_MRG>(p, grid, stream); launch_phase<PH_WO>(p, grid, stream); launch_phase<PH_GU2>(p, grid, stream);
    launch_phase<PH_DN2>(p, grid, stream); launch_phase<PH_LN3>(p, grid, stream);
#else
    static bool attr_done = false;
    if (!attr_done) {
        (void)hipFuncSetAttribute((const void*)k_fwd, hipFuncAttributeMaxDynamicSharedMemorySize, LDS_BYTES);
        int per_cu = 0;
        if (hipOccupancyMaxActiveBlocksPerMultiprocessor(&per_cu, (const void*)k_fwd, 512, LDS_BYTES) != hipSuccess || per_cu < 1)
            fprintf(stderr, "kernel_launch: occupancy query reports %d workgroups per CU for k_fwd (need 1)\n", per_cu);
        attr_done = true;
    }
    hipLaunchKernelGGL(k_fwd, dim3(grid), dim3(512), LDS_BYTES, stream, p);
    hipError_t e = hipGetLastError();
    if (e != hipSuccess) fprintf(stderr, "kernel_launch: launch failed: %s\n", hipGetErrorName(e));
#endif
}
```
